# Optimizing an MI355X kernel written in HIP

```python
import jax, jax.numpy as jnp
from jax import lax
import numpy as np

D_MODEL = 4096
BATCH = 8
SEQ = 2048
DEPTH = 2

MIX_WIDTH = D_MODEL
RWKV_WIDTH = MIX_WIDTH // 2
RWKV_HEAD_DIM = 64
RWKV_HEADS = RWKV_WIDTH // RWKV_HEAD_DIM
DECAY_LORA = 96
ICLR_LORA = 96
GATE_LORA = 256
RWKV_PROJ = 3 * RWKV_WIDTH + DECAY_LORA + ICLR_LORA + GATE_LORA
LNX_EPS = 64e-5
SBA_WIDTH = MIX_WIDTH - RWKV_WIDTH
SBA_HEAD_DIM = 64
SBA_HEADS = SBA_WIDTH // SBA_HEAD_DIM
SBA_PROJ = 3 * SBA_WIDTH
SBA_BLOCK = 128
W_IN0_COLS = RWKV_PROJ + SBA_PROJ
LRU_WIDTH = D_MODEL
LRU_HEADS = 16
LRU_BLOCK = LRU_WIDTH // LRU_HEADS
LRU_CONV = 4
LRU_C = 8.0
D_FF = 11008
FFN_CONV = 3
LN_EPS = 1e-5
DEEPNORM_ALPHA = (2 * DEPTH) ** 0.25
DEEPNORM_BETA = (8 * DEPTH) ** -0.25

kernel_name = "rwkv7_stickbreak_rglru_convffn_deepnorm"


def layer_norm(x, g, b):
    xf = x.astype(jnp.float32)
    mu = jnp.mean(xf, axis=-1, keepdims=True)
    var = jnp.mean(jnp.square(xf - mu), axis=-1, keepdims=True)
    y = (xf - mu) * lax.rsqrt(var + LN_EPS)
    return (y * g.astype(jnp.float32) + b.astype(jnp.float32)).astype(x.dtype)


def causal_depthwise_conv(x, w, b):
    K = w.shape[0]
    T = x.shape[1]
    xp = jnp.pad(x, ((0, 0), (K - 1, 0), (0, 0)))
    y = b + w[K - 1] * x
    for k in range(K - 1):
        y = y + w[k] * xp[:, k:k + T]
    return y


def token_shift(p):
    return jnp.pad(p, ((0, 0), (1, 0), (0, 0)))[:, :-1]


def rwkv7_mixer(p, shift_mu, decay_base, decay_up, iclr_base, iclr_up, gate_up,
                k_k, k_a, r_k, lnx_g, lnx_b):
    B, T, _ = p.shape
    f32 = jnp.float32
    p = p + (token_shift(p) - p) * shift_mu
    W = RWKV_WIDTH
    r, k, v, wd, ad, gd = jnp.split(
        p, [W, 2 * W, 3 * W, 3 * W + DECAY_LORA, 3 * W + DECAY_LORA + ICLR_LORA], axis=-1)
    w = -jax.nn.softplus(-(decay_base + jnp.tanh(wd) @ decay_up)) - 0.5
    decay = jnp.exp(-jnp.exp(w.astype(f32)))
    a = jax.nn.sigmoid(iclr_base + ad @ iclr_up)
    g = jax.nn.sigmoid(gd) @ gate_up
    heads = lambda t: t.astype(f32).reshape(B, T, RWKV_HEADS, RWKV_HEAD_DIM)
    kk = heads(k * k_k)
    kk = kk * lax.rsqrt(jnp.maximum(jnp.sum(kk * kk, axis=-1, keepdims=True), 1e-24))
    k = k * (1.0 + (a - 1.0) * k_a)
    r_h, k_h, v_h, w_h, a_h = heads(r), heads(k), heads(v), heads(decay), heads(a)
    b_h = kk * a_h

    def step(S, inp):
        r_t, w_t, k_t, v_t, kk_t, b_t = inp
        sa = jnp.einsum('bhvk,bhk->bhv', S, -kk_t)
        S = (S * w_t[:, :, None, :] + sa[..., None] * b_t[:, :, None, :]
             + v_t[..., None] * k_t[:, :, None, :])
        return S, jnp.einsum('bhvk,bhk->bhv', S, r_t)

    xs = tuple(jnp.moveaxis(t, 1, 0) for t in (r_h, w_h, k_h, v_h, kk, b_h))
    S0 = jnp.zeros((B, RWKV_HEADS, RWKV_HEAD_DIM, RWKV_HEAD_DIM), f32)
    _, y = lax.scan(step, S0, xs)
    y = jnp.moveaxis(y, 0, 1)
    mu = jnp.mean(y, axis=-1, keepdims=True)
    var = jnp.mean(jnp.square(y - mu), axis=-1, keepdims=True)
    y = ((y - mu) * lax.rsqrt(var + LNX_EPS)).reshape(B, T, W)
    y = y * lnx_g.astype(f32) + lnx_b.astype(f32)
    bonus = jnp.sum(r_h * k_h * r_k.astype(f32), axis=-1, keepdims=True) * v_h
    y = (y + bonus.reshape(B, T, W)) * g.astype(f32)
    return y.astype(p.dtype)


def stick_breaking_attention(p):
    B, T, _ = p.shape
    f32 = jnp.float32
    q, k, v = jnp.split(p.astype(f32), 3, axis=-1)
    to_heads = lambda t: t.reshape(B, T, SBA_HEADS, SBA_HEAD_DIM).transpose(0, 2, 1, 3)
    q = to_heads(q) * (SBA_HEAD_DIM ** -0.5)
    k, v = to_heads(k), to_heads(v)
    outs = []
    for blk in range(T // SBA_BLOCK):
        start = blk * SBA_BLOCK
        end = start + SBA_BLOCK
        qb = q[:, :, start:end]
        kb, vb = k[:, :, :end], v[:, :, :end]
        z = jnp.einsum('bhqd,bhkd->bhqk', qb, kb)
        t_idx = start + jnp.arange(SBA_BLOCK)[:, None]
        s_idx = jnp.arange(end)[None, :]
        mask = s_idx < t_idx
        log_keep = jnp.where(mask, jax.nn.log_sigmoid(-z), 0.0)
        between = lax.cumsum(log_keep, axis=3, reverse=True) - log_keep
        att = jnp.where(mask, jnp.exp(jax.nn.log_sigmoid(z) + between), 0.0)
        outs.append(jnp.einsum('bhqk,bhkd->bhqd', att, vb))
    o = jnp.concatenate(outs, axis=2)
    return o.transpose(0, 2, 1, 3).reshape(B, T, SBA_WIDTH).astype(p.dtype)


def conv_ffn(x, w_up, conv_w, conv_b, w_down):
    u = causal_depthwise_conv(x @ w_up, conv_w, conv_b)
    gate, val = jnp.split(u, 2, axis=-1)
    return (jax.nn.silu(gate) * val) @ w_down


def rglru_mixer(x, w_in, conv_w, conv_b, gate_r_w, gate_r_b, gate_i_w, gate_i_b, lam, w_out):
    B, T, _ = x.shape
    f32 = jnp.float32
    gate_branch, xb = jnp.split(x @ w_in, 2, axis=-1)
    xb = causal_depthwise_conv(xb, conv_w, conv_b)
    xh = xb.reshape(B, T, LRU_HEADS, LRU_BLOCK)
    r = jax.nn.sigmoid(jnp.einsum('bthi,hij->bthj', xh, gate_r_w).reshape(B, T, LRU_WIDTH) + gate_r_b)
    i = jax.nn.sigmoid(jnp.einsum('bthi,hij->bthj', xh, gate_i_w).reshape(B, T, LRU_WIDTH) + gate_i_b)
    log_a = -LRU_C * r.astype(f32) * jax.nn.softplus(-lam.astype(f32))
    a = jnp.exp(log_a)
    mult = jnp.sqrt(-jnp.expm1(2.0 * log_a))
    mult = jnp.where((jnp.arange(T) == 0)[None, :, None], 1.0, mult)
    u = mult * (i * xb).astype(f32)

    def combine(c1, c2):
        a1, b1 = c1
        a2, b2 = c2
        return a1 * a2, a2 * b1 + b2

    _, h = lax.associative_scan(combine, (a, u), axis=1)
    y = h.astype(x.dtype) * jax.nn.gelu(gate_branch, approximate=True)
    return y @ w_out


def even_layer(x, w_in, shift_mu, decay_base, decay_up, iclr_base, iclr_up, gate_up,
               k_k, k_a, r_k, lnx_g, lnx_b, w_out, ln_mix_g, ln_mix_b,
               ffn_up, ffn_conv_w, ffn_conv_b, ffn_down, ln_ffn_g, ln_ffn_b):
    p = x @ w_in
    y_a = rwkv7_mixer(p[..., :RWKV_PROJ], shift_mu, decay_base, decay_up, iclr_base, iclr_up,
                      gate_up, k_k, k_a, r_k, lnx_g, lnx_b)
    y_b = stick_breaking_attention(p[..., RWKV_PROJ:])
    mix = jnp.concatenate([y_a, y_b], axis=-1) @ w_out
    x = layer_norm(DEEPNORM_ALPHA * x + mix, ln_mix_g, ln_mix_b)
    x = layer_norm(DEEPNORM_ALPHA * x + conv_ffn(x, ffn_up, ffn_conv_w, ffn_conv_b, ffn_down),
                   ln_ffn_g, ln_ffn_b)
    return x


def odd_layer(x, w_in, conv_w, conv_b, gate_r_w, gate_r_b, gate_i_w, gate_i_b, lam, w_out,
              ln_mix_g, ln_mix_b, ffn_up, ffn_conv_w, ffn_conv_b, ffn_down, ln_ffn_g, ln_ffn_b):
    mix = rglru_mixer(x, w_in, conv_w, conv_b, gate_r_w, gate_r_b, gate_i_w, gate_i_b, lam, w_out)
    x = layer_norm(DEEPNORM_ALPHA * x + mix, ln_mix_g, ln_mix_b)
    x = layer_norm(DEEPNORM_ALPHA * x + conv_ffn(x, ffn_up, ffn_conv_w, ffn_conv_b, ffn_down),
                   ln_ffn_g, ln_ffn_b)
    return x


def setup_inputs(seed: int = 0) -> dict:
    key = jax.random.key(seed)
    keys = iter(jax.random.split(key, 64))
    nk = lambda: next(keys)
    nrm = lambda shape, scale: jax.random.normal(nk(), shape, jnp.float32) * scale
    gain = lambda n: 1.0 + nrm((n,), 0.02)
    bias = lambda n: nrm((n,), 0.02)
    d = {}
    d["x"] = nrm((BATCH, SEQ, D_MODEL), 1.0)
    d["l0_w_in"] = nrm((D_MODEL, W_IN0_COLS), D_MODEL ** -0.5)
    d["l0_shift_mu"] = jax.random.uniform(nk(), (RWKV_PROJ,), jnp.float32)
    d["l0_decay_base"] = jax.random.uniform(nk(), (RWKV_WIDTH,), jnp.float32, -5.0, 0.5)
    d["l0_decay_up"] = nrm((DECAY_LORA, RWKV_WIDTH), 0.1)
    d["l0_iclr_base"] = nrm((RWKV_WIDTH,), 0.1)
    d["l0_iclr_up"] = nrm((ICLR_LORA, RWKV_WIDTH), 0.5 * ICLR_LORA ** -0.5)
    d["l0_gate_up"] = nrm((GATE_LORA, RWKV_WIDTH), GATE_LORA ** -0.5)
    d["l0_k_k"] = 0.85 + nrm((RWKV_WIDTH,), 0.05)
    d["l0_k_a"] = 1.0 + nrm((RWKV_WIDTH,), 0.05)
    d["l0_r_k"] = nrm((RWKV_HEADS, RWKV_HEAD_DIM), 0.1)
    d["l0_lnx_g"] = gain(RWKV_WIDTH)
    d["l0_lnx_b"] = bias(RWKV_WIDTH)
    d["l0_w_out"] = nrm((MIX_WIDTH, D_MODEL), DEEPNORM_BETA * MIX_WIDTH ** -0.5)
    d["l0_ln_mix_g"] = gain(D_MODEL)
    d["l0_ln_mix_b"] = bias(D_MODEL)
    d["l0_ffn_up"] = nrm((D_MODEL, 2 * D_FF), D_MODEL ** -0.5)
    d["l0_ffn_conv_w"] = nrm((FFN_CONV, 2 * D_FF), FFN_CONV ** -0.5)
    d["l0_ffn_conv_b"] = bias(2 * D_FF)
    d["l0_ffn_down"] = nrm((D_FF, D_MODEL), DEEPNORM_BETA * D_FF ** -0.5)
    d["l0_ln_ffn_g"] = gain(D_MODEL)
    d["l0_ln_ffn_b"] = bias(D_MODEL)
    d["l1_w_in"] = nrm((D_MODEL, 2 * LRU_WIDTH), D_MODEL ** -0.5)
    d["l1_conv_w"] = nrm((LRU_CONV, LRU_WIDTH), LRU_CONV ** -0.5)
    d["l1_conv_b"] = bias(LRU_WIDTH)
    d["l1_gate_r_w"] = nrm((LRU_HEADS, LRU_BLOCK, LRU_BLOCK), LRU_BLOCK ** -0.5)
    d["l1_gate_r_b"] = bias(LRU_WIDTH)
    d["l1_gate_i_w"] = nrm((LRU_HEADS, LRU_BLOCK, LRU_BLOCK), LRU_BLOCK ** -0.5)
    d["l1_gate_i_b"] = bias(LRU_WIDTH)
    a_target = jax.random.uniform(nk(), (LRU_WIDTH,), jnp.float32, 0.9, 0.999)
    s = a_target ** (1.0 / LRU_C)
    d["l1_lambda"] = jnp.log(s) - jnp.log1p(-s)
    d["l1_w_out"] = nrm((LRU_WIDTH, D_MODEL), DEEPNORM_BETA * LRU_WIDTH ** -0.5)
    d["l1_ln_mix_g"] = gain(D_MODEL)
    d["l1_ln_mix_b"] = bias(D_MODEL)
    d["l1_ffn_up"] = nrm((D_MODEL, 2 * D_FF), D_MODEL ** -0.5)
    d["l1_ffn_conv_w"] = nrm((FFN_CONV, 2 * D_FF), FFN_CONV ** -0.5)
    d["l1_ffn_conv_b"] = bias(2 * D_FF)
    d["l1_ffn_down"] = nrm((D_FF, D_MODEL), DEEPNORM_BETA * D_FF ** -0.5)
    d["l1_ln_ffn_g"] = gain(D_MODEL)
    d["l1_ln_ffn_b"] = bias(D_MODEL)
    return d


def reference(x,
              l0_w_in, l0_shift_mu, l0_decay_base, l0_decay_up, l0_iclr_base, l0_iclr_up,
              l0_gate_up, l0_k_k, l0_k_a, l0_r_k, l0_lnx_g, l0_lnx_b, l0_w_out,
              l0_ln_mix_g, l0_ln_mix_b, l0_ffn_up, l0_ffn_conv_w, l0_ffn_conv_b, l0_ffn_down,
              l0_ln_ffn_g, l0_ln_ffn_b,
              l1_w_in, l1_conv_w, l1_conv_b, l1_gate_r_w, l1_gate_r_b, l1_gate_i_w, l1_gate_i_b,
              l1_lambda, l1_w_out, l1_ln_mix_g, l1_ln_mix_b, l1_ffn_up, l1_ffn_conv_w,
              l1_ffn_conv_b, l1_ffn_down, l1_ln_ffn_g, l1_ln_ffn_b):
    layer_params = (
        (l0_w_in, l0_shift_mu, l0_decay_base, l0_decay_up, l0_iclr_base, l0_iclr_up,
         l0_gate_up, l0_k_k, l0_k_a, l0_r_k, l0_lnx_g, l0_lnx_b, l0_w_out,
         l0_ln_mix_g, l0_ln_mix_b, l0_ffn_up, l0_ffn_conv_w, l0_ffn_conv_b, l0_ffn_down,
         l0_ln_ffn_g, l0_ln_ffn_b),
        (l1_w_in, l1_conv_w, l1_conv_b, l1_gate_r_w, l1_gate_r_b, l1_gate_i_w, l1_gate_i_b,
         l1_lambda, l1_w_out, l1_ln_mix_g, l1_ln_mix_b, l1_ffn_up, l1_ffn_conv_w,
         l1_ffn_conv_b, l1_ffn_down, l1_ln_ffn_g, l1_ln_ffn_b),
    )
    for layer in range(DEPTH):
        if layer % 2 == 0:
            x = even_layer(x, *layer_params[layer])
        else:
            x = odd_layer(x, *layer_params[layer])
    return x
```

```cpp
#include <hip/hip_runtime.h>
#include <cstdio>
#include <cstdint>

namespace pg8 {
#define PG8_LAS __attribute__((address_space(3)))
typedef unsigned short bf16_t;
typedef short bf16x8 __attribute__((ext_vector_type(8)));
typedef float f32x4 __attribute__((ext_vector_type(4)));
typedef unsigned u32x4 __attribute__((ext_vector_type(4)));
constexpr int BM = 256, BK = 64, HALF = 128, HTB = HALF * BK * 2  , STAGE_BYTES = 8 * HTB, NXCD = 8, WGM = 8;

__host__ __device__ __forceinline__ int lds_byte(int r, int c) { const int st = (r >> 4) * 2 + (c >> 5), rr = r & 15, cc = c & 31, ob = rr * 64 + cc * 2; return st * 1024 + (ob ^ (((ob >> 9) & 1) << 5)); }
__host__ __device__ __forceinline__ void stage_rc(int b, int& R, int& C) { const int st = b / 1024, sb = b % 1024, swz = sb ^ (((sb >> 9) & 1) << 5); R = (st >> 1) * 16 + swz / 64; C = (st & 1) * 32 + (swz % 64) / 2; }
__host__ __device__ __forceinline__ int perm32(int rho) { const int n = rho >> 4, i = rho & 15; return 8 * (i >> 2) + 4 * n + (i & 3); }

struct Unit { int pm, pn; };
struct Gemm { const bf16_t* A; const bf16_t* Bt; int M, N, K, lda, a_mod, a_stride; };

struct StaticOrder {
    int nM, nN, nwg, G, c;
    __host__ __device__ void init(int M, int N, int G_, int c_) { nM = M / BM; nN = N / BM; nwg = nM * nN; G = G_; c = c_; }
    __host__ __device__ bool next(int i, Unit& u) const {
        const long L = (long)i * G + c; if (L >= nwg) return false;
        int wgid = (int)L; { const int q = nwg / NXCD, r = nwg % NXCD, xcd = wgid % NXCD, off = wgid / NXCD; wgid = (xcd < r ? xcd * (q + 1) : r * (q + 1) + (xcd - r) * q) + off; }
        const int nig = WGM * nN, gid = wgid / nig, fm = gid * WGM, gsz = (nM - fm) < WGM ? (nM - fm) : WGM;
        u.pm = fm + ((wgid % nig) % gsz); u.pn = (wgid % nig) / gsz; return true;
    }
    __device__ __forceinline__ void a_ready(const Unit&) const {}
    __device__ __forceinline__ void done(const Unit&) const {}
};

__device__ __forceinline__ unsigned cvt_pk_bf16(float lo, float hi) { unsigned r; asm volatile("v_cvt_pk_bf16_f32 %0, %1, %2" : "=v"(r) : "v"(lo), "v"(hi)); return r; }

struct EpiBf16 {
    static constexpr bool PERM = true, AFTER_DRAIN = false;
    bf16_t* O; int ldc;
    __device__ __forceinline__ void operator()(const f32x4 (&acc)[2][2][4][2], const Unit& u, int wr, int wc, int fr, int fq) const {
        const int row0 = u.pm * BM + wr * 64 + fr; const int col0 = u.pn * BM + wc * 32 + 8 * fq;
#pragma unroll
        for (int ai = 0; ai < 2; ++ai)
#pragma unroll
            for (int m = 0; m < 4; ++m) { bf16_t* rowp = O + (size_t)(row0 + ai * HALF + m * 16) * ldc + col0;
#pragma unroll
                for (int bj = 0; bj < 2; ++bj) { const f32x4 v0 = acc[ai][bj][m][0], v1 = acc[ai][bj][m][1];
                    u32x4 w; w.x = cvt_pk_bf16(v0[0], v0[1]); w.y = cvt_pk_bf16(v0[2], v0[3]); w.z = cvt_pk_bf16(v1[0], v1[1]); w.w = cvt_pk_bf16(v1[2], v1[3]);
                    *(u32x4*)(rowp + bj * HALF) = w; } }
    }
};
struct EpiF32 {
    static constexpr bool PERM = false, AFTER_DRAIN = false;
    float* C; const float* base; int ldc; float alpha;
    __device__ __forceinline__ void operator()(const f32x4 (&acc)[2][2][4][2], const Unit& u, int wr, int wc, int fr, int fq) const {
        const int row0 = u.pm * BM + wr * 64 + fr, col0 = u.pn * BM + wc * 32 + 4 * fq;
#pragma unroll
        for (int ai = 0; ai < 2; ++ai)
#pragma unroll
            for (int m = 0; m < 4; ++m) { const size_t off = (size_t)(row0 + ai * HALF + m * 16) * ldc + col0;
                f32x4 bs[2][2];
#pragma unroll
                for (int bj = 0; bj < 2; ++bj)
#pragma unroll
                    for (int n = 0; n < 2; ++n) bs[bj][n] = base ? *(const f32x4*)(base + off + bj * HALF + n * 16) : (f32x4){0.f, 0.f, 0.f, 0.f};
#pragma unroll
                for (int bj = 0; bj < 2; ++bj)
#pragma unroll
                    for (int n = 0; n < 2; ++n) *(f32x4*)(C + off + bj * HALF + n * 16) = acc[ai][bj][m][n] + bs[bj][n] * alpha;
                asm volatile("" ::: "memory"); }
    }
};

template <class Epi, class Sched, bool ALIGN_EPI = false, bool SP2 = false>
__device__ __forceinline__ void gemm_phase(PG8_LAS unsigned char* lds, const Gemm g, const Sched& S, const Epi& E) {
    const int tid = threadIdx.x, wid = __builtin_amdgcn_readfirstlane(tid >> 6), lane = tid & 63, wr = wid >> 2, wc = wid & 3, fr = lane & 15, fq = lane >> 4;
    const int K = g.K, nt = K / BK;
    unsigned voffA[2], voffB[2];
#pragma unroll
    for (int i = 0; i < 2; ++i) { int R, C; stage_rc(tid * 16 + i * 8192, R, C); const int Rb = Epi::PERM ? ((R & ~31) + perm32(R & 31)) : R;
        voffA[i] = (unsigned)(R * g.lda + C) * 2u; voffB[i] = (unsigned)(Rb * K + C) * 2u; }
    const size_t kstep = (size_t)(BK * 2);
    const size_t hstepA = (size_t)HALF * g.lda * 2, hstepB = (size_t)HALF * K * 2;
    const size_t tstepA = 2 * hstepA, tstepB = 2 * hstepB;
    const unsigned ldsw = (unsigned)wid * 1024u;
    const int aoff = lds_byte(wr * 64 + fr, fq * 8), boff = lds_byte(wc * 32 + fr, fq * 8);
#define PG8_ABASE(u) ((const char*)g.A + (size_t)(u).pm * tstepA + (g.a_mod ? (size_t)((u).pn % g.a_mod) * g.a_stride * 2 : (size_t)0))
#define PG8_SA(b, h) (((b) * 2 + (h)) * HTB)
#define PG8_SB(b, h) ((4 + (b) * 2 + (h)) * HTB)
#define PG8_STAGE(bufoff, gbase, voff) do { _Pragma("unroll") for (int _i = 0; _i < 2; ++_i) \
        __builtin_amdgcn_global_load_lds((const unsigned*)((const char*)(gbase) + (voff)[_i]), (PG8_LAS unsigned*)(lds + (bufoff) + ldsw + _i * 8192), 16, 0, 0); } while (0)
#define PG8_LDA(dst, b, h) do { _Pragma("unroll") for (int m = 0; m < 4; ++m) _Pragma("unroll") for (int k = 0; k < 2; ++k) dst[m][k] = *(const PG8_LAS bf16x8*)(lds + PG8_SA(b, h) + aoff + m * 2048 + k * 1024); } while (0)
#define PG8_LDB(dst, b, h) do { _Pragma("unroll") for (int n = 0; n < 2; ++n) _Pragma("unroll") for (int k = 0; k < 2; ++k) dst[n][k] = *(const PG8_LAS bf16x8*)(lds + PG8_SB(b, h) + boff + n * 2048 + k * 1024); } while (0)
#define PG8_MMA(ai, bj, At, Bt) do { __builtin_amdgcn_s_setprio(1); _Pragma("unroll") for (int m = 0; m < 4; ++m) _Pragma("unroll") for (int n = 0; n < 2; ++n) _Pragma("unroll") for (int k = 0; k < 2; ++k) \
        acc[ai][bj][m][n] = __builtin_amdgcn_mfma_f32_16x16x32_bf16(Bt[n][k], At[m][k], acc[ai][bj][m][n], 0, 0, 0); __builtin_amdgcn_s_setprio(0); } while (0)
#define PG8_WAIT_V(n) asm volatile("s_waitcnt vmcnt(" #n ")" ::: "memory")
#define PG8_WAIT_L(n) asm volatile("s_waitcnt lgkmcnt(" #n ")" ::: "memory")
#define PG8_BAR __builtin_amdgcn_s_barrier()
#define PG8_SCHED __builtin_amdgcn_sched_barrier(0)
    Unit cur, nxt; int ui = 0;
    if (!S.next(0, cur)) return;
    f32x4 acc[2][2][4][2];
#pragma unroll
    for (int a = 0; a < 2; ++a)
#pragma unroll
        for (int b = 0; b < 2; ++b)
#pragma unroll
            for (int m = 0; m < 4; ++m)
#pragma unroll
                for (int n = 0; n < 2; ++n) acc[a][b][m][n] = (f32x4){0.f, 0.f, 0.f, 0.f};
    bf16x8 At[4][2], B0[2][2], B1[2][2];
    const char* cA = PG8_ABASE(cur); const char* cB = (const char*)g.Bt + (size_t)cur.pn * tstepB;
    S.a_ready(cur);
    if constexpr (SP2) {
        PG8_STAGE(PG8_SB(0, 0), cB, voffB); PG8_STAGE(PG8_SB(0, 1), cB + hstepB, voffB); PG8_STAGE(PG8_SA(0, 0), cA, voffA); PG8_STAGE(PG8_SA(0, 1), cA + hstepA, voffA);
        if (wr == 1) PG8_BAR;
        PG8_WAIT_V(2); PG8_BAR;
        PG8_STAGE(PG8_SB(1, 0), cB + kstep, voffB); PG8_STAGE(PG8_SA(1, 0), cA + kstep, voffA); PG8_STAGE(PG8_SB(1, 1), cB + hstepB + kstep, voffB);
        PG8_WAIT_V(6); PG8_BAR;
    } else {
        PG8_STAGE(PG8_SB(0, 0), cB, voffB); PG8_STAGE(PG8_SA(0, 0), cA, voffA); PG8_STAGE(PG8_SB(0, 1), cB + hstepB, voffB); PG8_STAGE(PG8_SA(0, 1), cA + hstepA, voffA);
        if (wr == 1) PG8_BAR;
        PG8_WAIT_V(4); PG8_BAR;
        PG8_STAGE(PG8_SB(1, 0), cB + kstep, voffB); PG8_STAGE(PG8_SA(1, 0), cA + kstep, voffA); PG8_STAGE(PG8_SB(1, 1), cB + hstepB + kstep, voffB);
        PG8_WAIT_V(6); PG8_BAR;
    }
    for (;;) {
        const bool has_next = S.next(ui + 1, nxt);
        const char* nA = has_next ? PG8_ABASE(nxt) : cA; const char* nB = has_next ? (const char*)g.Bt + (size_t)nxt.pn * tstepB : cB;
        for (int t = 0; t < nt; t += 2) {
            const bool last = (t == nt - 2);
            const char* a1 = cA + (size_t)(t + 1) * kstep;
            const char* a2 = last ? nA : cA + (size_t)(t + 2) * kstep; const char* b2 = last ? nB : cB + (size_t)(t + 2) * kstep;
            const char* a3 = a2 + kstep; const char* b3 = b2 + kstep;
            if (last && has_next) S.a_ready(nxt);
            if constexpr (SP2) {
            PG8_LDB(B0, 0, 0); PG8_LDB(B1, 0, 1); PG8_SCHED; PG8_LDA(At, 0, 0); PG8_STAGE(PG8_SA(1, 1), a1 + hstepA, voffA);
            PG8_WAIT_V(8); PG8_WAIT_L(0); PG8_BAR; PG8_MMA(0, 0, At, B0); PG8_MMA(0, 1, At, B1); PG8_BAR; PG8_SCHED;
            PG8_LDA(At, 0, 1); PG8_STAGE(PG8_SB(0, 0), b2, voffB); PG8_STAGE(PG8_SB(0, 1), b2 + hstepB, voffB); PG8_STAGE(PG8_SA(0, 0), a2, voffA);
            PG8_WAIT_V(8); PG8_WAIT_L(0); PG8_BAR; PG8_MMA(1, 0, At, B0); PG8_MMA(1, 1, At, B1); PG8_BAR; PG8_SCHED;
            PG8_LDB(B0, 1, 0); PG8_LDB(B1, 1, 1); PG8_SCHED; PG8_LDA(At, 1, 0); PG8_STAGE(PG8_SA(0, 1), a2 + hstepA, voffA);
            PG8_WAIT_V(8); PG8_WAIT_L(0); PG8_BAR; PG8_MMA(0, 0, At, B0); PG8_MMA(0, 1, At, B1); PG8_BAR; PG8_SCHED;
            PG8_LDA(At, 1, 1); PG8_STAGE(PG8_SB(1, 0), b3, voffB); PG8_STAGE(PG8_SB(1, 1), b3 + hstepB, voffB); PG8_STAGE(PG8_SA(1, 0), a3, voffA);
            PG8_WAIT_V(8); PG8_WAIT_L(0); PG8_BAR; PG8_MMA(1, 0, At, B0); PG8_MMA(1, 1, At, B1); PG8_BAR; PG8_SCHED;
            } else {
            PG8_LDB(B0, 0, 0); PG8_SCHED; PG8_LDA(At, 0, 0); PG8_STAGE(PG8_SA(1, 1), a1 + hstepA, voffA);
            PG8_WAIT_L(8); PG8_BAR; PG8_WAIT_L(0); PG8_MMA(0, 0, At, B0); PG8_BAR; PG8_SCHED;
            PG8_LDB(B1, 0, 1); PG8_STAGE(PG8_SB(0, 0), b2, voffB);
            PG8_BAR; PG8_WAIT_L(0); PG8_MMA(0, 1, At, B1); PG8_BAR;
            PG8_LDA(At, 0, 1); PG8_STAGE(PG8_SA(0, 0), a2, voffA);
            PG8_BAR; PG8_WAIT_L(0); PG8_MMA(1, 0, At, B0); PG8_BAR; PG8_SCHED;
            PG8_STAGE(PG8_SB(0, 1), b2 + hstepB, voffB);
            PG8_WAIT_V(6); PG8_BAR; PG8_MMA(1, 1, At, B1); PG8_BAR;
            PG8_LDB(B0, 1, 0); PG8_SCHED; PG8_LDA(At, 1, 0); PG8_STAGE(PG8_SA(0, 1), a2 + hstepA, voffA);
            PG8_WAIT_L(8); PG8_BAR; PG8_WAIT_L(0); PG8_MMA(0, 0, At, B0); PG8_BAR; PG8_SCHED;
            PG8_LDB(B1, 1, 1); PG8_STAGE(PG8_SB(1, 0), b3, voffB);
            PG8_BAR; PG8_WAIT_L(0); PG8_MMA(0, 1, At, B1); PG8_BAR;
            PG8_LDA(At, 1, 1); PG8_STAGE(PG8_SA(1, 0), a3, voffA);
            PG8_BAR; PG8_WAIT_L(0); PG8_MMA(1, 0, At, B0); PG8_BAR; PG8_SCHED;
            PG8_STAGE(PG8_SB(1, 1), b3 + hstepB, voffB);
            PG8_WAIT_V(6); PG8_BAR; PG8_MMA(1, 1, At, B1); PG8_BAR;
            }
        }
        if constexpr (ALIGN_EPI) { if (wr == 0) PG8_BAR; }
        E(acc, cur, wr, wc, fr, fq); S.done(cur);
        if (!has_next) break;
#pragma unroll
        for (int a = 0; a < 2; ++a)
#pragma unroll
            for (int b = 0; b < 2; ++b)
#pragma unroll
                for (int m = 0; m < 4; ++m)
#pragma unroll
                    for (int n = 0; n < 2; ++n) acc[a][b][m][n] = (f32x4){0.f, 0.f, 0.f, 0.f};
        cur = nxt; cA = nA; cB = nB; ++ui;
        if constexpr (ALIGN_EPI) { if (wr == 1) PG8_BAR; }
    }
    PG8_WAIT_V(0);
    if constexpr (!ALIGN_EPI) { if (wr == 0) PG8_BAR; }
    PG8_BAR;
#undef PG8_ABASE
#undef PG8_SA
#undef PG8_SB
#undef PG8_STAGE
#undef PG8_LDA
#undef PG8_LDB
#undef PG8_MMA
#undef PG8_WAIT_V
#undef PG8_WAIT_L
#undef PG8_BAR
#undef PG8_SCHED
}
}

constexpr int NWAVES = 8, NTHR = 512;
constexpr int BATCH = 8, T = 2048, D = 4096, M = BATCH * T;
constexpr int RW = 2048, RPROJ = 6592, SPROJ = 6144, NIN0 = RPROJ + SPROJ  , NIN0P = 12800;
constexpr int FF = 11008, FF2 = 22016;
constexpr int MH = M / 2;
constexpr float LN_EPS = 1e-5f, LNX_EPS = 64e-5f;
constexpr float DN_ALPHA = 1.41421356237309515f;

#ifndef MK_PER_PHASE
#define MK_PER_PHASE 1
#endif
constexpr int NPHASE = 26;

constexpr size_t MiB = 1u << 20;
constexpr size_t WS_CTL = 0, CTL_ZERO_BYTES = 64 * 1024;
constexpr size_t WS_WIN = 2 * MiB, WS_WOUT = 102 * MiB, WS_WUP = 134 * MiB, WS_WDOWN = 306 * MiB, WS_WL1 = 392 * MiB, WS_WG2 = 394 * MiB, WS_WGATES = 395 * MiB;
constexpr size_t WS_A0 = 400 * MiB;
constexpr size_t WS_BIG = 528 * MiB;
constexpr size_t WS_Y = 928 * MiB;
constexpr size_t WS_S = 1056 * MiB;
constexpr size_t WS_U = 1312 * MiB;
constexpr size_t WS_END = 1656 * MiB;
constexpr int CW_BAR = 4096;

constexpr int RING_OFF = 0, RING_BYTES = 131072;
constexpr int LDSCTL_OFF = RING_BYTES, MISC_OFF = LDSCTL_OFF + 320;
constexpr int LDS_BYTES = 147456;

#define LAS __attribute__((address_space(3)))
typedef unsigned short bf16;
typedef unsigned v4u __attribute__((ext_vector_type(4)));
typedef unsigned v2u __attribute__((ext_vector_type(2)));
typedef float f32x4 __attribute__((ext_vector_type(4)));
#define RLX_AGENT __ATOMIC_RELAXED, __HIP_MEMORY_SCOPE_AGENT
__device__ __forceinline__ unsigned f2bf(float f) { unsigned u = __builtin_bit_cast(unsigned, f); return (u + 0x7fffu + ((u >> 16) & 1u)) >> 16; }
__device__ __forceinline__ unsigned pk2(float lo, float hi) { return f2bf(lo) | (f2bf(hi) << 16); }
__device__ __forceinline__ float bflo(unsigned w) { return __uint_as_float(w << 16); }
__device__ __forceinline__ float bfhi(unsigned w) { return __uint_as_float(w & 0xffff0000u); }
__device__ __forceinline__ float sigmoidf_(float x) { return 1.0f / (1.0f + __expf(-x)); }
__device__ __forceinline__ float softplusf_(float x) { return fmaxf(x, 0.f) + log1pf(__expf(-fabsf(x))); }

#define XB_TMO      128
#define XB_XCNT(j)  (256  + 64 * (j))
#define XB_XSUB(j)  (1280 + 64 * (j))
#define XB_XGEN(j)  (2304 + 64 * (j))
#define XB_TOP      3328
#define XB_TOPGEN   3392
#define XCD_BAR_WORDS 3456
#define XB_SPIN_CAP (1u << 23)

__device__ __forceinline__ unsigned xb_ld(unsigned* p)              { return __hip_atomic_load(p, __ATOMIC_RELAXED, __HIP_MEMORY_SCOPE_AGENT); }
__device__ __forceinline__ unsigned xb_add(unsigned* p, unsigned v) { return __hip_atomic_fetch_add(p, v, __ATOMIC_RELAXED, __HIP_MEMORY_SCOPE_AGENT); }
__device__ __forceinline__ unsigned xb_xcc_id() { return (unsigned)__builtin_amdgcn_s_getreg((3 << 11) | 20) & 0xFu; }
#define XB_SPIN(cond, bar) do { unsigned _sp = 0; while (cond) { __builtin_amdgcn_s_sleep(1); \
    if ((++_sp & 255u) == 0u) { if (xb_ld(&(bar)[XB_TMO])) break; if (_sp > XB_SPIN_CAP) { atomicAdd(&(bar)[XB_TMO], 1u); break; } } } } while (0)

struct XcdBarrier {
    unsigned* bar; unsigned x;
    volatile LAS unsigned* st;
};
__device__ __forceinline__ XcdBarrier xcd_barrier_post(unsigned* bar, volatile LAS unsigned* st) {
    XcdBarrier b; b.bar = bar; b.x = xb_xcc_id(); b.st = st;
    if (threadIdx.x == 0) (void)xb_add(&bar[XB_XCNT(b.x)], 1u);
    return b;
}
__device__ __forceinline__ void xcd_barrier_complete(unsigned* bar, unsigned x, unsigned& nloc, unsigned& nx) {
    const unsigned G = gridDim.x * gridDim.y * gridDim.z;
    unsigned sum, cnt, mine, sp = 0u;
    for (;;) {
        sum = 0u; cnt = 0u; mine = 0u;
#pragma unroll
        for (unsigned j = 0; j < 16; ++j) { const unsigned c = xb_ld(&bar[XB_XCNT(j)]); sum += c; cnt += (c > 0u) ? 1u : 0u; mine = (j == x) ? c : mine; }
        if (sum == G) break;
        __builtin_amdgcn_s_sleep(1);
        if ((++sp & 255u) == 0u) { if (xb_ld(&bar[XB_TMO])) break; if (sp > XB_SPIN_CAP) { atomicAdd(&bar[XB_TMO], 1u); break; } }
    }
    nloc = mine > 0u ? mine : 1u; nx = cnt > 0u ? cnt : 1u;
}
__device__ __forceinline__ void xcd_barrier(const XcdBarrier& b) {
    asm volatile("s_waitcnt vmcnt(0)" ::: "memory");
    __syncthreads();
    if (threadIdx.x == 0) {
        unsigned* bar = b.bar;
        __builtin_amdgcn_s_waitcnt(0);
        unsigned nloc = b.st[0], nx = b.st[1];
        if (nloc == 0u) { xcd_barrier_complete(bar, b.x, nloc, nx); b.st[0] = nloc; b.st[1] = nx; }
        const unsigned old = xb_add(&bar[XB_XSUB(b.x)], 1u);
        const unsigned gen = old / nloc;
        if (old + 1u == (gen + 1u) * nloc) {
            __builtin_amdgcn_fence(__ATOMIC_RELEASE, "agent");
            asm volatile("s_waitcnt vmcnt(0)" ::: "memory");
            const unsigned og = xb_add(&bar[XB_TOP], 1u);
            const unsigned tg = og / nx;
            if (og + 1u == (tg + 1u) * nx) xb_add(&bar[XB_TOPGEN], 1u);
            else XB_SPIN(xb_ld(&bar[XB_TOPGEN]) == tg, bar);
            __builtin_amdgcn_fence(__ATOMIC_ACQUIRE, "agent");
            xb_add(&bar[XB_XGEN(b.x)], 1u);
            asm volatile("s_waitcnt vmcnt(0)" ::: "memory");
        } else {
            XB_SPIN(xb_ld(&bar[XB_XGEN(b.x)]) == gen, bar);
            __builtin_amdgcn_fence(__ATOMIC_ACQUIRE, "agent");
            asm volatile("s_waitcnt vmcnt(0)" ::: "memory");
        }
    }
    __syncthreads();
}

__device__ __forceinline__ void transpose_item(const float* W, int K, int N, bf16* WT, int row_off, LAS float* scr, int item, int lane) {
    const int nblk = N / 32, kb = item / nblk, nb = item % nblk, k0 = 64 * kb, n0 = 32 * nb;
#pragma unroll 8
    for (int i = 0; i < 32; ++i) { const int kk = 2 * i + (lane >> 5); scr[kk * 33 + (lane & 31)] = W[(size_t)(k0 + kk) * N + n0 + (lane & 31)]; }
    asm volatile("s_waitcnt lgkmcnt(0)" ::: "memory");
    const int c = lane & 7;
#pragma unroll
    for (int j = 0; j < 4; ++j) { const int n = (lane >> 3) + 8 * j; const LAS float* s = scr + (8 * c) * 33 + n;
        v4u o; o.x = pk2(s[0 * 33], s[1 * 33]); o.y = pk2(s[2 * 33], s[3 * 33]); o.z = pk2(s[4 * 33], s[5 * 33]); o.w = pk2(s[6 * 33], s[7 * 33]);
        *(v4u*)(WT + (size_t)(row_off + n0 + n) * K + k0 + 8 * c) = o; }
    asm volatile("s_waitcnt lgkmcnt(0)" ::: "memory");
}
__device__ __forceinline__ float wave_sum(float v) {
#pragma unroll
    for (int o = 1; o < 64; o <<= 1) v += __shfl_xor(v, o);
    return v;
}
__device__ __forceinline__ void ln_row(const float* src, const float* g, const float* bta, float* dstf, bf16* dstb, int lane) {
    const f32x4* xr = (const f32x4*)src + lane;
    f32x4 v[16]; float s = 0.f;
#pragma unroll
    for (int j = 0; j < 16; ++j) { v[j] = xr[64 * j]; s += (v[j].x + v[j].y) + (v[j].z + v[j].w); }
    const float mean = wave_sum(s) * (1.f / D); float s2 = 0.f;
#pragma unroll
    for (int j = 0; j < 16; ++j) { v[j] = v[j] - mean; s2 += (v[j].x * v[j].x + v[j].y * v[j].y) + (v[j].z * v[j].z + v[j].w * v[j].w); }
    const float rstd = 1.f / sqrtf(wave_sum(s2) * (1.f / D) + LN_EPS);
#pragma unroll
    for (int j = 0; j < 16; ++j) {
        const f32x4 gg = ((const f32x4*)g)[lane + 64 * j], bb = ((const f32x4*)bta)[lane + 64 * j];
        const f32x4 o = v[j] * rstd * gg + bb;
        ((f32x4*)dstf)[lane + 64 * j] = o;
        if (dstb) { v2u w; w.x = pk2(o.x, o.y); w.y = pk2(o.z, o.w); ((v2u*)dstb)[lane + 64 * j] = w; }
    }
}
__device__ __forceinline__ void unpack8(const v4u w, float (&f)[8]) {
    f[0] = bflo(w.x); f[1] = bfhi(w.x); f[2] = bflo(w.y); f[3] = bfhi(w.y); f[4] = bflo(w.z); f[5] = bfhi(w.z); f[6] = bflo(w.w); f[7] = bfhi(w.w);
}
__device__ __forceinline__ v4u pack8(const float (&f)[8]) { v4u w; w.x = pk2(f[0], f[1]); w.y = pk2(f[2], f[3]); w.z = pk2(f[4], f[5]); w.w = pk2(f[6], f[7]); return w; }

struct Args { const float* in[39]; float* out; unsigned char* ws; int ph_lo, ph_hi; };

__device__ __forceinline__ void rwkv_head(const Args& a, LAS float* L, int bh, const bf16* p, const float* wa, const bf16* gbuf, bf16* Y) {
    const int tid = threadIdx.x, lane = tid & 63, w = tid >> 6;
    const int b = bh >> 5, h = bh & 31;
    LAS float* VEC = L; LAS float* VV = L + 5 * 2048; LAS float* YY = L + 6 * 2048; LAS float* SC = L + 7 * 2048;
    const int r = lane >> 3, kq = lane & 7, vrow = 8 * w + r;
    const int ptok = tid >> 4, cq = tid & 15, c0 = 4 * cq, hc = h * 64 + c0;
    const f32x4 mu_r = *(const f32x4*)(a.in[2] + hc), mu_k = *(const f32x4*)(a.in[2] + 2048 + hc), mu_v = *(const f32x4*)(a.in[2] + 4096 + hc);
    const f32x4 dbase = *(const f32x4*)(a.in[3] + hc), ibase = *(const f32x4*)(a.in[5] + hc), kkp = *(const f32x4*)(a.in[8] + hc), kap = *(const f32x4*)(a.in[9] + hc);
    const f32x4 rkp = *(const f32x4*)(a.in[10] + hc), lg = *(const f32x4*)(a.in[11] + hc), lb = *(const f32x4*)(a.in[12] + hc);
    float s[8];
#pragma unroll
    for (int j = 0; j < 8; ++j) s[j] = 0.f;
    for (int chunk = 0; chunk < T / 32; ++chunk) {
        const int t = chunk * 32 + ptok; const size_t m = (size_t)b * T + t;
        {
            const bf16* prow = p + m * NIN0P + hc;
            const v2u r1 = *(const v2u*)(prow), k1 = *(const v2u*)(prow + 2048), v1 = *(const v2u*)(prow + 4096);
            v2u r0 = (v2u){0u, 0u}, k0 = r0, v0 = r0;
            if (t > 0) { r0 = *(const v2u*)(prow - NIN0P); k0 = *(const v2u*)(prow - NIN0P + 2048); v0 = *(const v2u*)(prow - NIN0P + 4096); }
            const f32x4 wpre = *(const f32x4*)(wa + m * 4096 + hc), apre = *(const f32x4*)(wa + m * 4096 + 2048 + hc);
            const f32x4 rc = (f32x4){bflo(r1.x), bfhi(r1.x), bflo(r1.y), bfhi(r1.y)}, rp = (f32x4){bflo(r0.x), bfhi(r0.x), bflo(r0.y), bfhi(r0.y)};
            const f32x4 kc = (f32x4){bflo(k1.x), bfhi(k1.x), bflo(k1.y), bfhi(k1.y)}, kp = (f32x4){bflo(k0.x), bfhi(k0.x), bflo(k0.y), bfhi(k0.y)};
            const f32x4 vc = (f32x4){bflo(v1.x), bfhi(v1.x), bflo(v1.y), bfhi(v1.y)}, vp = (f32x4){bflo(v0.x), bfhi(v0.x), bflo(v0.y), bfhi(v0.y)};
            const f32x4 rr = rc + (rp - rc) * mu_r, kx = kc + (kp - kc) * mu_k, vx = vc + (vp - vc) * mu_v;
            f32x4 dec, av, kkr, k2; float ss = 0.f;
#pragma unroll
            for (int j = 0; j < 4; ++j) {
                const float zw = dbase[j] + wpre[j];
                const float wlog = -softplusf_(-zw) - 0.5f;
                dec[j] = __expf(-__expf(wlog));
                av[j] = sigmoidf_(ibase[j] + apre[j]);
                kkr[j] = kx[j] * kkp[j]; ss += kkr[j] * kkr[j];
                k2[j] = kx[j] * (1.0f + (av[j] - 1.0f) * kap[j]);
            }
            ss += __shfl_xor(ss, 1); ss += __shfl_xor(ss, 2); ss += __shfl_xor(ss, 4); ss += __shfl_xor(ss, 8);
            const float inv = 1.0f / sqrtf(fmaxf(ss, 1e-24f));
            const f32x4 kkn = kkr * inv, bb = kkn * av, wr = dec * rr;
            float br = 0.f, kr = 0.f, bon = 0.f;
#pragma unroll
            for (int j = 0; j < 4; ++j) { br += bb[j] * rr[j]; kr += k2[j] * rr[j]; bon += rr[j] * k2[j] * rkp[j]; }
            br += __shfl_xor(br, 1); br += __shfl_xor(br, 2); br += __shfl_xor(br, 4); br += __shfl_xor(br, 8);
            kr += __shfl_xor(kr, 1); kr += __shfl_xor(kr, 2); kr += __shfl_xor(kr, 4); kr += __shfl_xor(kr, 8);
            bon += __shfl_xor(bon, 1); bon += __shfl_xor(bon, 2); bon += __shfl_xor(bon, 4); bon += __shfl_xor(bon, 8);
            const int o = ptok * 64 + c0;
            *(LAS f32x4*)(VEC + 0 * 2048 + o) = kkn; *(LAS f32x4*)(VEC + 1 * 2048 + o) = wr; *(LAS f32x4*)(VEC + 2 * 2048 + o) = dec;
            *(LAS f32x4*)(VEC + 3 * 2048 + o) = bb;  *(LAS f32x4*)(VEC + 4 * 2048 + o) = k2; *(LAS f32x4*)(VV + o) = vx;
            if (cq == 0) *(LAS f32x4*)(SC + 4 * ptok) = (f32x4){br, kr, bon, 0.f};
        }
        __syncthreads();
        for (int i = 0; i < 32; ++i) {
            const LAS f32x4* q0 = (const LAS f32x4*)(VEC + i * 64 + 8 * kq);
            const f32x4 kka = q0[0], kkb = q0[1], wra = q0[512], wrb = q0[513], wa_ = q0[1024], wb_ = q0[1025], ba = q0[1536], bb_ = q0[1537], ka = q0[2048], kb = q0[2049];
            const float vv = VV[i * 64 + vrow]; const f32x4 sc = *(const LAS f32x4*)(SC + 4 * i);
            float psa = 0.f, py = 0.f;
#pragma unroll
            for (int j = 0; j < 4; ++j) { psa += s[j] * kka[j]; py += s[j] * wra[j]; }
#pragma unroll
            for (int j = 0; j < 4; ++j) { psa += s[4 + j] * kkb[j]; py += s[4 + j] * wrb[j]; }
            psa += __shfl_xor(psa, 1); psa += __shfl_xor(psa, 2); psa += __shfl_xor(psa, 4);
            py += __shfl_xor(py, 1); py += __shfl_xor(py, 2); py += __shfl_xor(py, 4);
            const float sa = -psa;
#pragma unroll
            for (int j = 0; j < 4; ++j) { s[j] = s[j] * wa_[j] + sa * ba[j] + vv * ka[j]; s[4 + j] = s[4 + j] * wb_[j] + sa * bb_[j] + vv * kb[j]; }
            const float y = py + sa * sc[0] + vv * sc[1];
            if (kq == 0) YY[i * 64 + vrow] = y;
        }
        __syncthreads();
        {
            const int o = ptok * 64 + c0;
            const f32x4 y4 = *(const LAS f32x4*)(YY + o), vx = *(const LAS f32x4*)(VV + o); const float bon = SC[4 * ptok + 2];
            float s1 = (y4[0] + y4[1]) + (y4[2] + y4[3]);
            s1 += __shfl_xor(s1, 1); s1 += __shfl_xor(s1, 2); s1 += __shfl_xor(s1, 4); s1 += __shfl_xor(s1, 8);
            const float mean = s1 * (1.f / 64.f); const f32x4 d = y4 - mean;
            float s2 = (d[0] * d[0] + d[1] * d[1]) + (d[2] * d[2] + d[3] * d[3]);
            s2 += __shfl_xor(s2, 1); s2 += __shfl_xor(s2, 2); s2 += __shfl_xor(s2, 4); s2 += __shfl_xor(s2, 8);
            const float rstd = 1.0f / sqrtf(s2 * (1.f / 64.f) + LNX_EPS);
            const v2u gw = *(const v2u*)(gbuf + m * 2048 + hc);
            const f32x4 gv = (f32x4){bflo(gw.x), bfhi(gw.x), bflo(gw.y), bfhi(gw.y)};
            const f32x4 res = (d * rstd * lg + lb + vx * bon) * gv;
            v2u ow; ow.x = pk2(res[0], res[1]); ow.y = pk2(res[2], res[3]);
            *(v2u*)(Y + m * D + hc) = ow;
        }
        __syncthreads();
    }
}

__device__ __forceinline__ void sba_task(LAS float* Lw, int task, const bf16* p, bf16* Y, int lane) {
    const int qb = task & 31, h = (task >> 5) & 31, b = task >> 10;
    LAS float* Kf = Lw; LAS float* Vf = Lw + 2048;
    const int t = qb * 64 + lane; const size_t m = (size_t)b * T + t;
    float q[64], o[64];
    { const v4u* qp = (const v4u*)(p + m * NIN0P + RPROJ + h * 64);
#pragma unroll
      for (int j = 0; j < 8; ++j) { float f[8]; unpack8(qp[j], f);
#pragma unroll
          for (int e = 0; e < 8; ++e) { q[8 * j + e] = f[e] * 0.125f; o[8 * j + e] = 0.f; } } }
    float R = 0.f;
    for (int kb = 2 * qb + 1; kb >= 0; --kb) {
        const int s0 = kb * 32;
        {
            const int key = lane >> 1, hf = lane & 1;
            const bf16* src = p + ((size_t)b * T + s0 + key) * NIN0P + RPROJ + 2048 + h * 64 + hf * 32;
#pragma unroll
            for (int j = 0; j < 4; ++j) { float f[8]; unpack8(((const v4u*)src)[j], f);
                *(LAS f32x4*)(Kf + key * 64 + hf * 32 + 8 * j) = (f32x4){f[0], f[1], f[2], f[3]}; *(LAS f32x4*)(Kf + key * 64 + hf * 32 + 8 * j + 4) = (f32x4){f[4], f[5], f[6], f[7]}; }
#pragma unroll
            for (int j = 0; j < 4; ++j) { float f[8]; unpack8(((const v4u*)(src + 2048))[j], f);
                *(LAS f32x4*)(Vf + key * 64 + hf * 32 + 8 * j) = (f32x4){f[0], f[1], f[2], f[3]}; *(LAS f32x4*)(Vf + key * 64 + hf * 32 + 8 * j + 4) = (f32x4){f[4], f[5], f[6], f[7]}; }
        }
        asm volatile("s_waitcnt lgkmcnt(0)" ::: "memory");
        for (int kk = 31; kk >= 0; --kk) {
            const int sidx = s0 + kk;
            const LAS f32x4* kr = (const LAS f32x4*)(Kf + kk * 64);
            float z0 = 0.f, z1 = 0.f, z2 = 0.f, z3 = 0.f;
#pragma unroll
            for (int j = 0; j < 16; ++j) { const f32x4 kv = kr[j]; z0 += q[4 * j] * kv[0]; z1 += q[4 * j + 1] * kv[1]; z2 += q[4 * j + 2] * kv[2]; z3 += q[4 * j + 3] * kv[3]; }
            const float z = (z0 + z1) + (z2 + z3);
            const bool valid = sidx < t;
            const float sp = softplusf_(z);
            const float att = valid ? __expf(z - sp + R) : 0.f;
            R = valid ? R - sp : R;
            const LAS f32x4* vr = (const LAS f32x4*)(Vf + kk * 64);
#pragma unroll
            for (int j = 0; j < 16; ++j) { const f32x4 vv = vr[j]; o[4 * j] += att * vv[0]; o[4 * j + 1] += att * vv[1]; o[4 * j + 2] += att * vv[2]; o[4 * j + 3] += att * vv[3]; }
        }
        asm volatile("s_waitcnt lgkmcnt(0)" ::: "memory");
        if (__all(R < -120.0f)) break;
    }
    { v4u* op = (v4u*)(Y + m * D + RW + h * 64);
#pragma unroll
      for (int j = 0; j < 8; ++j) { float f[8];
#pragma unroll
          for (int e = 0; e < 8; ++e) f[e] = o[8 * j + e];
          op[j] = pack8(f); } }
}

__device__ __forceinline__ void lru_task(const Args& a, LAS float* L, int task, const bf16* RI, const bf16* xbc, const bf16* gg, bf16* Y) {
    const int tid = threadIdx.x, lane = tid & 63, w = tid >> 6;
    const int b = task >> 6, c = (task & 63) * 64 + lane;
    const float rb = a.in[26][c], ib = a.in[28][c], sl = 8.0f * softplusf_(-a.in[29][c]);
    const size_t m0 = (size_t)b * T + 256 * w;
    float P = 1.f, H = 0.f;
#pragma unroll 4
    for (int i = 0; i < 256; ++i) {
        const size_t m = m0 + i;
        const float rp = __uint_as_float((unsigned)RI[m * 8192 + c] << 16), ip = __uint_as_float((unsigned)RI[m * 8192 + 4096 + c] << 16), xv = __uint_as_float((unsigned)xbc[m * D + c] << 16);
        const float rg = sigmoidf_(rp + rb), ig = sigmoidf_(ip + ib);
        const float la = -rg * sl; const float av = __expf(la);
        float mult = sqrtf(-expm1f(2.0f * la)); if (w == 0 && i == 0) mult = 1.0f;
        const float u = mult * ig * xv;
        H = av * H + u; P *= av;
    }
    L[(w * 64 + lane) * 2] = P; L[(w * 64 + lane) * 2 + 1] = H;
    __syncthreads();
    float hc = 0.f;
    for (int j = 0; j < w; ++j) hc = L[(j * 64 + lane) * 2] * hc + L[(j * 64 + lane) * 2 + 1];
    H = hc;
#pragma unroll 4
    for (int i = 0; i < 256; ++i) {
        const size_t m = m0 + i;
        const float rp = __uint_as_float((unsigned)RI[m * 8192 + c] << 16), ip = __uint_as_float((unsigned)RI[m * 8192 + 4096 + c] << 16), xv = __uint_as_float((unsigned)xbc[m * D + c] << 16);
        const float gv = __uint_as_float((unsigned)gg[m * D + c] << 16);
        const float rg = sigmoidf_(rp + rb), ig = sigmoidf_(ip + ib);
        const float la = -rg * sl; const float av = __expf(la);
        float mult = sqrtf(-expm1f(2.0f * la)); if (w == 0 && i == 0) mult = 1.0f;
        const float u = mult * ig * xv;
        H = av * H + u;
        Y[m * D + c] = (bf16)f2bf(H * gv);
    }
    __syncthreads();
}


#define IN(k) (lo <= (k) && (k) < hi)
#define SEAM(k) do { if (IN(k) && IN((k) + 1)) xcd_barrier(bar); } while (0)

template <int hf>
__device__ __forceinline__ void ffn_half(const Args& args, LAS unsigned char* lds, const XcdBarrier& bar, const int pb, const float* cw, const float* cb) {
    const int tid = threadIdx.x;
    const int G = gridDim.x, bx = blockIdx.x;
    const size_t gt = (size_t)bx * NTHR + tid, NGT = (size_t)G * NTHR;
    unsigned char* ws = args.ws;
    const int lo = args.ph_lo, hi = args.ph_hi;
    bf16* Wup = (bf16*)(ws + WS_WUP); bf16* A0 = (bf16*)(ws + WS_A0); bf16* BIG = (bf16*)(ws + WS_BIG); bf16* Uh = (bf16*)(ws + WS_U);
            if (IN(pb + 7 + 2 * hf)) { pg8::Gemm g{A0 + (size_t)hf * MH * D, Wup, MH, FF2, D, D, 0, 0}; pg8::StaticOrder S; S.init(MH, FF2, G, bx); pg8::EpiBf16 E{Uh, FF2};
                pg8::gemm_phase<pg8::EpiBf16, pg8::StaticOrder, true, true>(lds + RING_OFF, g, S, E); }
            SEAM(pb + 7 + 2 * hf);
            if (IN(pb + 8 + 2 * hf)) {
                for (size_t i = gt; i < (size_t)MH * (FF / 8); i += NGT) {
                    const int mu = (int)(i / (FF / 8)), c = (int)(i % (FF / 8)) * 8, t = mu & (T - 1);
                    float ag[8], av[8];
                    { const f32x4 b0 = *(const f32x4*)(cb + c), b1 = *(const f32x4*)(cb + c + 4), d0 = *(const f32x4*)(cb + FF + c), d1 = *(const f32x4*)(cb + FF + c + 4);
#pragma unroll
                      for (int e = 0; e < 8; ++e) { ag[e] = e < 4 ? b0[e] : b1[e - 4]; av[e] = e < 4 ? d0[e] : d1[e - 4]; } }
#pragma unroll
                    for (int dt = 0; dt < 3; ++dt) {
                        if (t - dt >= 0) { float xg[8], xv[8]; unpack8(*(const v4u*)(Uh + (size_t)(mu - dt) * FF2 + c), xg); unpack8(*(const v4u*)(Uh + (size_t)(mu - dt) * FF2 + FF + c), xv);
                            const float* wr_ = cw + (size_t)(2 - dt) * FF2;
                            const f32x4 g0 = *(const f32x4*)(wr_ + c), g1 = *(const f32x4*)(wr_ + c + 4), v0 = *(const f32x4*)(wr_ + FF + c), v1 = *(const f32x4*)(wr_ + FF + c + 4);
#pragma unroll
                            for (int e = 0; e < 8; ++e) { ag[e] += (e < 4 ? g0[e] : g1[e - 4]) * xg[e]; av[e] += (e < 4 ? v0[e] : v1[e - 4]) * xv[e]; } }
                    }
                    float hv[8];
#pragma unroll
                    for (int e = 0; e < 8; ++e) hv[e] = ag[e] * sigmoidf_(ag[e]) * av[e];
                    *(v4u*)(BIG + ((size_t)hf * MH + mu) * FF + c) = pack8(hv);
                }
            }
            SEAM(pb + 8 + 2 * hf);
        }
template <int Lyr>
__device__ __forceinline__ void layer_body(const Args& args, LAS unsigned char* lds, const XcdBarrier& bar) {
    const int tid = threadIdx.x, lane = tid & 63, wave = __builtin_amdgcn_readfirstlane(tid >> 6);
    const int G = gridDim.x, bx = blockIdx.x;
    const int gw = bx * NWAVES + wave, NGW = G * NWAVES;
    const size_t gt = (size_t)bx * NTHR + tid, NGT = (size_t)G * NTHR;
    unsigned char* ws = args.ws;
    const int lo = args.ph_lo, hi = args.ph_hi;
    bf16* Win = (bf16*)(ws + WS_WIN); bf16* Wout = (bf16*)(ws + WS_WOUT); bf16* Wup = (bf16*)(ws + WS_WUP); bf16* Wdown = (bf16*)(ws + WS_WDOWN);
    bf16* Wl1 = (bf16*)(ws + WS_WL1); bf16* Wg2 = (bf16*)(ws + WS_WG2); bf16* Wgates = (bf16*)(ws + WS_WGATES);
    bf16* A0 = (bf16*)(ws + WS_A0); bf16* BIG = (bf16*)(ws + WS_BIG); bf16* Yb = (bf16*)(ws + WS_Y); float* Sf = (float*)(ws + WS_S);
    bf16* Uh = (bf16*)(ws + WS_U);
    float* WApre = (float*)(ws + WS_U); bf16* Gb = (bf16*)(ws + WS_U + 256 * MiB); bf16* Ap = (bf16*)(ws + WS_U + 320 * MiB); bf16* Gp = (bf16*)(ws + WS_U + 328 * MiB);
    bf16* XBC = (bf16*)(ws + WS_BIG + 256 * MiB); bf16* RI = (bf16*)(ws + WS_U);

        const int pb = Lyr * 13;
        const float* w_out = Lyr ? args.in[30] : args.in[13];
        const float* ln1g = Lyr ? args.in[31] : args.in[14]; const float* ln1b = Lyr ? args.in[32] : args.in[15];
        const float* ffn_up = Lyr ? args.in[33] : args.in[16]; const float* cw = Lyr ? args.in[34] : args.in[17]; const float* cb = Lyr ? args.in[35] : args.in[18];
        const float* ffn_down = Lyr ? args.in[36] : args.in[19];
        const float* ln2g = Lyr ? args.in[37] : args.in[20]; const float* ln2b = Lyr ? args.in[38] : args.in[21];
        const float* w_in = Lyr ? args.in[22] : args.in[1];
        const int n_in = Lyr ? 8192 : NIN0;

        if (IN(pb + 0)) {
            LAS float* scr = (LAS float*)(lds + RING_OFF + wave * 16384);
            const int I_IN = 64 * (n_in / 32), I_OUT = 64 * 128, I_UP = 64 * 688, I_DOWN = 172 * 128, I_X = Lyr ? 32 * 32 : 4 * 64;
            const int NIT = I_IN + I_OUT + I_UP + I_DOWN + I_X;
            for (int it = gw; it < NIT; it += NGW) {
                int r = it;
                if (r < I_IN) { transpose_item(w_in, D, n_in, Win, 0, scr, r, lane); continue; } r -= I_IN;
                if (r < I_OUT) { transpose_item(w_out, D, D, Wout, 0, scr, r, lane); continue; } r -= I_OUT;
                if (r < I_UP) { transpose_item(ffn_up, D, FF2, Wup, 0, scr, r, lane); continue; } r -= I_UP;
                if (r < I_DOWN) { transpose_item(ffn_down, FF, D, Wdown, 0, scr, r, lane); continue; } r -= I_DOWN;
                if (Lyr == 0) transpose_item(args.in[7], 256, 2048, Wg2, 0, scr, r, lane);
                else { const int mat = r >> 5, sub = r & 31, gsel = mat >> 4, hh = mat & 15;
                    transpose_item((gsel ? args.in[27] : args.in[25]) + (size_t)hh * 65536, 256, 256, Wgates, mat * 256, scr, sub, lane); }
            }
            if (Lyr == 0) {
                for (size_t i = gt; i < (size_t)64 * D / 8; i += NGT) ((v4u*)(Win + (size_t)NIN0 * D))[i] = (v4u){0u, 0u, 0u, 0u};
                for (size_t i = gt; i < (size_t)4096 * 256; i += NGT) { const int n = (int)(i >> 8), k = (int)(i & 255); float v = 0.f;
                    if (n < 2048) { if (k < 96) v = args.in[4][(size_t)k * 2048 + n]; } else { if (k >= 96 && k < 192) v = args.in[6][(size_t)(k - 96) * 2048 + (n - 2048)]; }
                    Wl1[i] = (bf16)f2bf(v); }
                for (size_t i = gt; i < (size_t)M * D / 8; i += NGT) { const f32x4 v0 = ((const f32x4*)args.in[0])[2 * i], v1 = ((const f32x4*)args.in[0])[2 * i + 1];
                    v4u o; o.x = pk2(v0.x, v0.y); o.y = pk2(v0.z, v0.w); o.z = pk2(v1.x, v1.y); o.w = pk2(v1.z, v1.w); ((v4u*)A0)[i] = o; }
            }
        }
        SEAM(pb + 0);

        if (Lyr == 0) {
            if (IN(1)) { pg8::Gemm g{A0, Win, M, NIN0P, D, D, 0, 0}; pg8::StaticOrder S; S.init(M, NIN0P, G, bx); pg8::EpiBf16 E{BIG, NIN0P};
                pg8::gemm_phase<pg8::EpiBf16, pg8::StaticOrder, true, true>(lds + RING_OFF, g, S, E); }
            SEAM(1);
            if (IN(2)) {
                for (int m = gw; m < M; m += NGW) {
                    const int t = m & (T - 1); const int sl = 8 * lane;
                    const bool isA = sl < 256; const int pc = isA ? 6144 + sl : 6336 + (sl - 256);
                    float f[8];
                    if (isA && sl >= 192) {
#pragma unroll
                        for (int e = 0; e < 8; ++e) f[e] = 0.f;
                    } else {
                        float c1[8], c0[8]; unpack8(*(const v4u*)(BIG + (size_t)m * NIN0P + pc), c1);
                        if (t > 0) unpack8(*(const v4u*)(BIG + (size_t)(m - 1) * NIN0P + pc), c0); else {
#pragma unroll
                            for (int e = 0; e < 8; ++e) c0[e] = 0.f; }
                        const f32x4 mu0 = *(const f32x4*)(args.in[2] + pc), mu1 = *(const f32x4*)(args.in[2] + pc + 4);
#pragma unroll
                        for (int e = 0; e < 8; ++e) { const float mu = e < 4 ? mu0[e] : mu1[e - 4]; const float xv = c1[e] + (c0[e] - c1[e]) * mu;
                            f[e] = isA ? (sl < 96 ? tanhf(xv) : xv) : sigmoidf_(xv); }
                    }
                    if (isA) *(v4u*)(Ap + (size_t)m * 256 + sl) = pack8(f); else *(v4u*)(Gp + (size_t)m * 256 + (sl - 256)) = pack8(f);
                }
            }
            SEAM(2);
            if (IN(3)) {
                { pg8::Gemm g{Ap, Wl1, M, 4096, 256, 256, 0, 0}; pg8::StaticOrder S; S.init(M, 4096, G, bx); pg8::EpiF32 E{WApre, nullptr, 4096, 0.f};
                  pg8::gemm_phase<pg8::EpiF32, pg8::StaticOrder, true, true>(lds + RING_OFF, g, S, E); }
                __syncthreads();
                { pg8::Gemm g{Gp, Wg2, M, 2048, 256, 256, 0, 0}; pg8::StaticOrder S; S.init(M, 2048, G, bx); pg8::EpiBf16 E{Gb, 2048};
                  pg8::gemm_phase<pg8::EpiBf16, pg8::StaticOrder, true, true>(lds + RING_OFF, g, S, E); }
            }
            SEAM(3);
            if (IN(4)) {
                for (int bh = bx; bh < BATCH * 32; bh += G) rwkv_head(args, (LAS float*)(lds + RING_OFF), bh, BIG, WApre, Gb, Yb);
                __syncthreads();
                for (int task = gw; task < BATCH * 32 * 32; task += NGW) sba_task((LAS float*)(lds + RING_OFF + wave * 16384), task, BIG, Yb, lane);
                __syncthreads();
            }
            SEAM(4);
        } else {
            if (IN(14)) { pg8::Gemm g{A0, Win, M, 8192, D, D, 0, 0}; pg8::StaticOrder S; S.init(M, 8192, G, bx); pg8::EpiBf16 E{BIG, 8192};
                pg8::gemm_phase<pg8::EpiBf16, pg8::StaticOrder, true, true>(lds + RING_OFF, g, S, E); }
            SEAM(14);
            if (IN(15)) {
                for (size_t i = gt; i < (size_t)M * 512; i += NGT) {
                    const int m = (int)(i >> 9), c = (int)(i & 511) * 8, t = m & (T - 1);
                    float gv[8]; unpack8(*(const v4u*)(BIG + (size_t)m * 8192 + c), gv);
#pragma unroll
                    for (int e = 0; e < 8; ++e) { const float x = gv[e]; gv[e] = 0.5f * x * (1.0f + tanhf(0.7978845608028654f * (x + 0.044715f * x * x * x))); }
                    *(v4u*)(A0 + (size_t)m * D + c) = pack8(gv);
                    float acc[8];
                    { const f32x4 b0 = *(const f32x4*)(args.in[24] + c), b1 = *(const f32x4*)(args.in[24] + c + 4);
#pragma unroll
                      for (int e = 0; e < 8; ++e) acc[e] = e < 4 ? b0[e] : b1[e - 4]; }
#pragma unroll
                    for (int dt = 0; dt < 4; ++dt) {
                        if (t - dt >= 0) { float xv[8]; unpack8(*(const v4u*)(BIG + (size_t)(m - dt) * 8192 + 4096 + c), xv);
                            const f32x4 w0 = *(const f32x4*)(args.in[23] + (size_t)(3 - dt) * D + c), w1 = *(const f32x4*)(args.in[23] + (size_t)(3 - dt) * D + c + 4);
#pragma unroll
                            for (int e = 0; e < 8; ++e) acc[e] += (e < 4 ? w0[e] : w1[e - 4]) * xv[e]; }
                    }
                    *(v4u*)(XBC + (size_t)m * D + c) = pack8(acc);
                }
            }
            SEAM(15);
            if (IN(16)) { pg8::Gemm g{XBC, Wgates, M, 8192, 256, D, 16, 256}; pg8::StaticOrder S; S.init(M, 8192, G, bx); pg8::EpiBf16 E{RI, 8192};
                pg8::gemm_phase<pg8::EpiBf16, pg8::StaticOrder, true, true>(lds + RING_OFF, g, S, E); }
            SEAM(16);
            if (IN(17)) { for (int task = bx; task < BATCH * 64; task += G) lru_task(args, (LAS float*)(lds + RING_OFF), task, RI, XBC, A0, Yb); }
            SEAM(17);
        }

        if (IN(pb + 5)) { pg8::Gemm g{Yb, Wout, M, D, D, D, 0, 0}; pg8::StaticOrder S; S.init(M, D, G, bx);
            pg8::EpiF32 E{Sf, Lyr ? (const float*)Sf : args.in[0], D, DN_ALPHA};
            pg8::gemm_phase<pg8::EpiF32, pg8::StaticOrder, true, true>(lds + RING_OFF, g, S, E); }
        SEAM(pb + 5);
        if (IN(pb + 6)) { for (int m = gw; m < M; m += NGW) ln_row(Sf + (size_t)m * D, ln1g, ln1b, Sf + (size_t)m * D, A0 + (size_t)m * D, lane); }
        SEAM(pb + 6);
        ffn_half<0>(args, lds, bar, pb, cw, cb);
        ffn_half<1>(args, lds, bar, pb, cw, cb);
        if (IN(pb + 11)) { pg8::Gemm g{BIG, Wdown, M, D, FF, FF, 0, 0}; pg8::StaticOrder S; S.init(M, D, G, bx); pg8::EpiF32 E{Sf, Sf, D, DN_ALPHA};
            pg8::gemm_phase<pg8::EpiF32, pg8::StaticOrder, true, true>(lds + RING_OFF, g, S, E); }
        SEAM(pb + 11);
        if (IN(pb + 12)) { for (int m = gw; m < M; m += NGW) ln_row(Sf + (size_t)m * D, ln2g, ln2b, Lyr ? args.out + (size_t)m * D : Sf + (size_t)m * D, Lyr ? (bf16*)nullptr : A0 + (size_t)m * D, lane); }
        SEAM(pb + 12);
    }
__global__ void __launch_bounds__(NTHR, 2) trunk_fwd(Args args) {
    extern __shared__ __attribute__((aligned(16))) unsigned char lds_raw[];
    LAS unsigned char* lds = (LAS unsigned char*)lds_raw;
    volatile LAS unsigned* MISC = (volatile LAS unsigned*)(lds + MISC_OFF);
    const int tid = threadIdx.x, lane = tid & 63, wave = __builtin_amdgcn_readfirstlane(tid >> 6);
    const int G = gridDim.x, bx = blockIdx.x;
    const int gw = bx * NWAVES + wave, NGW = G * NWAVES;
    const size_t gt = (size_t)bx * NTHR + tid, NGT = (size_t)G * NTHR;
    unsigned char* ws = args.ws;
    unsigned* ctl = (unsigned*)(ws + WS_CTL);
    for (int u = tid; u < (LDS_BYTES - LDSCTL_OFF) / 4; u += NTHR) ((LAS unsigned*)(lds + LDSCTL_OFF))[u] = 0u;
    __syncthreads();
    XcdBarrier bar; bar.bar = ctl + CW_BAR; bar.x = 0; bar.st = nullptr;
    if (!MK_PER_PHASE) bar = xcd_barrier_post(ctl + CW_BAR, MISC + 8);

    layer_body<0>(args, lds, bar);
    layer_body<1>(args, lds, bar);
}


extern "C" void kernel_launch(void* const* d_in, const int* in_sizes, int n_in, void* d_out, int out_size, void* d_ws, size_t ws_size, hipStream_t stream) {
    static int grid = 0;
    if (grid == 0) {
        if (n_in != 39 || in_sizes[0] != M * D || out_size != M * D || ws_size < WS_END) {
            fprintf(stderr, "kernel_launch: unexpected shapes: n_in %d in0 %d out %d ws %zu (need %zu); nothing launched\n", n_in, n_in > 0 ? in_sizes[0] : -1, out_size, ws_size, (size_t)WS_END); grid = -1; return; }
        int dev = 0, cus = 0, per_cu = 0;
        if (hipGetDevice(&dev) != hipSuccess || hipDeviceGetAttribute(&cus, hipDeviceAttributeMultiprocessorCount, dev) != hipSuccess) { grid = -1; return; }
        if (hipFuncSetAttribute((const void*)trunk_fwd, hipFuncAttributeMaxDynamicSharedMemorySize, LDS_BYTES) != hipSuccess) { fprintf(stderr, "kernel_launch: hipFuncSetAttribute failed\n"); grid = -1; return; }
        if (hipOccupancyMaxActiveBlocksPerMultiprocessor(&per_cu, (const void*)trunk_fwd, NTHR, LDS_BYTES) != hipSuccess || per_cu < 1)
            fprintf(stderr, "kernel_launch: note: occupancy query reports %d workgroups per CU\n", per_cu);
        (void)hipGetLastError();
        grid = cus;
    }
    if (grid < 0) return;
    if (hipMemsetAsync((char*)d_ws + WS_CTL, 0, CTL_ZERO_BYTES, stream) != hipSuccess) return;
    Args a{};
    for (int i = 0; i < 39; ++i) a.in[i] = (const float*)d_in[i];
    a.out = (float*)d_out; a.ws = (unsigned char*)d_ws;
#if MK_PER_PHASE
    for (int ph = 0; ph < NPHASE; ++ph) { a.ph_lo = ph; a.ph_hi = ph + 1; hipLaunchKernelGGL(trunk_fwd, dim3(grid), dim3(NTHR), LDS_BYTES, stream, a); }
#else
    a.ph_lo = 0; a.ph_hi = NPHASE;
    hipLaunchKernelGGL(trunk_fwd, dim3(grid), dim3(NTHR), LDS_BYTES, stream, a);
#endif
    const hipError_t le = hipPeekAtLastError();
    if (le != hipSuccess) fprintf(stderr, "kernel_launch: launch failed: %s\n", hipGetErrorName(le));
}
```

```cpp
#include <hip/hip_runtime.h>
#include <cstdio>
#include <cstdint>

namespace pg8 {
#define PG8_LAS __attribute__((address_space(3)))
typedef unsigned short bf16_t;
typedef short bf16x8 __attribute__((ext_vector_type(8)));
typedef float f32x4 __attribute__((ext_vector_type(4)));
typedef unsigned u32x4 __attribute__((ext_vector_type(4)));
constexpr int BM = 256, BK = 64, HALF = 128, HTB = HALF * BK * 2  , STAGE_BYTES = 8 * HTB, NXCD = 8, WGM = 8;

__host__ __device__ __forceinline__ int lds_byte(int r, int c) { const int st = (r >> 4) * 2 + (c >> 5), rr = r & 15, cc = c & 31, ob = rr * 64 + cc * 2; return st * 1024 + (ob ^ (((ob >> 9) & 1) << 5)); }
__host__ __device__ __forceinline__ void stage_rc(int b, int& R, int& C) { const int st = b / 1024, sb = b % 1024, swz = sb ^ (((sb >> 9) & 1) << 5); R = (st >> 1) * 16 + swz / 64; C = (st & 1) * 32 + (swz % 64) / 2; }
__host__ __device__ __forceinline__ int perm32(int rho) { const int n = rho >> 4, i = rho & 15; return 8 * (i >> 2) + 4 * n + (i & 3); }

struct Unit { int pm, pn; };
struct Gemm { const bf16_t* A; const bf16_t* Bt; int M, N, K, lda, a_mod, a_stride, a_shift; };

struct StaticOrder {
    int nM, nN, nwg, G, c;
    __host__ __device__ void init(int M, int N, int G_, int c_) { nM = M / BM; nN = N / BM; nwg = nM * nN; G = G_; c = c_; }
    __host__ __device__ bool next(int i, Unit& u) const {
        const long L = (long)i * G + c; if (L >= nwg) return false;
        int wgid = (int)L; { const int q = nwg / NXCD, r = nwg % NXCD, xcd = wgid % NXCD, off = wgid / NXCD; wgid = (xcd < r ? xcd * (q + 1) : r * (q + 1) + (xcd - r) * q) + off; }
        const int nig = WGM * nN, gid = wgid / nig, fm = gid * WGM, gsz = (nM - fm) < WGM ? (nM - fm) : WGM;
        u.pm = fm + ((wgid % nig) % gsz); u.pn = (wgid % nig) / gsz; return true;
    }
    __device__ __forceinline__ void a_ready(const Unit&) const {}
    __device__ __forceinline__ void done(const Unit&) const {}
};

__device__ __forceinline__ unsigned cvt_pk_bf16(float lo, float hi) { unsigned r; asm volatile("v_cvt_pk_bf16_f32 %0, %1, %2" : "=v"(r) : "v"(lo), "v"(hi)); return r; }

struct EpiBf16 {
    static constexpr bool PERM = true, AFTER_DRAIN = false, TOKPERM = false;
    bf16_t* O; int ldc;
    __device__ __forceinline__ void operator()(const f32x4 (&acc)[2][2][4][2], const Unit& u, int wr, int wc, int fr, int fq) const {
        const int row0 = u.pm * BM + wr * 64 + fr; const int col0 = u.pn * BM + wc * 32 + 8 * fq;
#pragma unroll
        for (int ai = 0; ai < 2; ++ai)
#pragma unroll
            for (int m = 0; m < 4; ++m) { bf16_t* rowp = O + (size_t)(row0 + ai * HALF + m * 16) * ldc + col0;
#pragma unroll
                for (int bj = 0; bj < 2; ++bj) { const f32x4 v0 = acc[ai][bj][m][0], v1 = acc[ai][bj][m][1];
                    u32x4 w; w.x = cvt_pk_bf16(v0[0], v0[1]); w.y = cvt_pk_bf16(v0[2], v0[3]); w.z = cvt_pk_bf16(v1[0], v1[1]); w.w = cvt_pk_bf16(v1[2], v1[3]);
                    *(u32x4*)(rowp + bj * HALF) = w; } }
    }
};
template <bool LNB> struct EpiF32T {
    static constexpr bool PERM = false, AFTER_DRAIN = false, TOKPERM = false;
    float* C; const float* base; int ldc; float alpha; const float* stats; const float* lg; const float* lb;
    __device__ __forceinline__ void operator()(const f32x4 (&acc)[2][2][4][2], const Unit& u, int wr, int wc, int fr, int fq) const {
        float* const C = this->C; const float* const base = this->base; const float* const stats = this->stats; const int ldc = this->ldc; const float alpha = this->alpha;
        const int row0 = u.pm * BM + wr * 64 + fr, col0 = u.pn * BM + wc * 32 + 4 * fq;
        f32x4 gv[2][2], bv[2][2];
        if constexpr (LNB) {
#pragma unroll
            for (int bj = 0; bj < 2; ++bj)
#pragma unroll
                for (int n = 0; n < 2; ++n) { gv[bj][n] = *(const f32x4*)(lg + col0 + bj * HALF + n * 16) * alpha; bv[bj][n] = *(const f32x4*)(lb + col0 + bj * HALF + n * 16) * alpha; }
        }
#pragma unroll
        for (int ai = 0; ai < 2; ++ai)
#pragma unroll
            for (int m = 0; m < 4; ++m) { const int row = row0 + ai * HALF + m * 16; const size_t off = (size_t)row * ldc + col0;
                f32x4 bs[2][2];
#pragma unroll
                for (int bj = 0; bj < 2; ++bj)
#pragma unroll
                    for (int n = 0; n < 2; ++n) bs[bj][n] = base ? *(const f32x4*)(base + off + bj * HALF + n * 16) : (f32x4){0.f, 0.f, 0.f, 0.f};
                if constexpr (LNB) { const float mean = stats[2 * row], rstd = stats[2 * row + 1];
#pragma unroll
                    for (int bj = 0; bj < 2; ++bj)
#pragma unroll
                        for (int n = 0; n < 2; ++n) *(f32x4*)(C + off + bj * HALF + n * 16) = acc[ai][bj][m][n] + ((bs[bj][n] - mean) * rstd * gv[bj][n] + bv[bj][n]);
                } else {
#pragma unroll
                    for (int bj = 0; bj < 2; ++bj)
#pragma unroll
                        for (int n = 0; n < 2; ++n) *(f32x4*)(C + off + bj * HALF + n * 16) = acc[ai][bj][m][n] + bs[bj][n] * alpha;
                }
                asm volatile("" ::: "memory"); }
    }
};

template <bool LNB, bool OUTF32, bool XBF = false> struct EpiRes {
    static constexpr bool PERM = true, AFTER_DRAIN = false, TOKPERM = false;
    void* Cout; const void* base; const float* stats; const float* lg; const float* lb;
    __device__ __forceinline__ void operator()(const f32x4 (&acc)[2][2][4][2], const Unit& u, int wr, int wc, int fr, int fq) const {
        void* const Cout = this->Cout; const void* const base = this->base; const float* const stats = this->stats; const float* const lg = this->lg; const float* const lb = this->lb;
        constexpr float alpha = 1.41421356237309515f; constexpr int ldc = 4096;
        const int row0 = u.pm * BM + wr * 64 + fr, col0 = u.pn * BM + wc * 32 + 8 * fq;
        f32x4 g0[2], g1[2], b0[2], b1[2];
        if constexpr (LNB) {
#pragma unroll
            for (int bj = 0; bj < 2; ++bj) { g0[bj] = *(const f32x4*)(lg + col0 + bj * HALF) * alpha; g1[bj] = *(const f32x4*)(lg + col0 + bj * HALF + 4) * alpha;
                b0[bj] = *(const f32x4*)(lb + col0 + bj * HALF) * alpha; b1[bj] = *(const f32x4*)(lb + col0 + bj * HALF + 4) * alpha; }
        }
#pragma unroll
        for (int ai = 0; ai < 2; ++ai)
#pragma unroll
            for (int m = 0; m < 4; ++m) { const int row = row0 + ai * HALF + m * 16; const size_t off = (size_t)row * ldc + col0;
                f32x4 x0[2], x1[2];
#pragma unroll
                for (int bj = 0; bj < 2; ++bj) {
                    if constexpr (LNB) { const u32x4 w = *(const u32x4*)((const bf16_t*)base + off + bj * HALF);
                        x0[bj] = (f32x4){__uint_as_float(w.x << 16), __uint_as_float(w.x & 0xffff0000u), __uint_as_float(w.y << 16), __uint_as_float(w.y & 0xffff0000u)};
                        x1[bj] = (f32x4){__uint_as_float(w.z << 16), __uint_as_float(w.z & 0xffff0000u), __uint_as_float(w.w << 16), __uint_as_float(w.w & 0xffff0000u)}; }
                    else if constexpr (XBF) { const u32x4 w = *(const u32x4*)((const bf16_t*)base + off + bj * HALF);
                        x0[bj] = (f32x4){__uint_as_float(w.x << 16), __uint_as_float(w.x & 0xffff0000u), __uint_as_float(w.y << 16), __uint_as_float(w.y & 0xffff0000u)};
                        x1[bj] = (f32x4){__uint_as_float(w.z << 16), __uint_as_float(w.z & 0xffff0000u), __uint_as_float(w.w << 16), __uint_as_float(w.w & 0xffff0000u)}; }
                    else { x0[bj] = *(const f32x4*)((const float*)base + off + bj * HALF); x1[bj] = *(const f32x4*)((const float*)base + off + bj * HALF + 4); }
                }
                float mean = 0.f, rstd = 0.f; if constexpr (LNB) { mean = stats[2 * row]; rstd = stats[2 * row + 1]; }
#pragma unroll
                for (int bj = 0; bj < 2; ++bj) { f32x4 o0, o1;
                    if constexpr (LNB) { o0 = acc[ai][bj][m][0] + ((x0[bj] - mean) * rstd * g0[bj] + b0[bj]); o1 = acc[ai][bj][m][1] + ((x1[bj] - mean) * rstd * g1[bj] + b1[bj]); }
                    else { o0 = acc[ai][bj][m][0] + x0[bj] * alpha; o1 = acc[ai][bj][m][1] + x1[bj] * alpha; }
                    if constexpr (OUTF32) { *(f32x4*)((float*)Cout + off + bj * HALF) = o0; *(f32x4*)((float*)Cout + off + bj * HALF + 4) = o1; }
                    else { u32x4 w; w.x = cvt_pk_bf16(o0[0], o0[1]); w.y = cvt_pk_bf16(o0[2], o0[3]); w.z = cvt_pk_bf16(o1[0], o1[1]); w.w = cvt_pk_bf16(o1[2], o1[3]); *(u32x4*)((bf16_t*)Cout + off + bj * HALF) = w; }
                }
                if (m & 1) __builtin_amdgcn_sched_barrier(0); }
    }
};

template <int CTRL> __device__ __forceinline__ float dppf(float v) { return __builtin_bit_cast(float, __builtin_amdgcn_update_dpp(0, __builtin_bit_cast(int, v), CTRL, 0xF, 0xF, true)); }
struct EpiFfnUp {
    static constexpr bool PERM = true, AFTER_DRAIN = false, TOKPERM = true;
    bf16_t* Hout; const float* cw; const float* cb; float* SB; int ff;
    __device__ __forceinline__ void operator()(const f32x4 (&acc)[2][2][4][2], const Unit& u, int wr, int wc, int fr, int fq) const {
        const int tb = u.pm * BM + wr * 128 + fr * 8;
        const int hc0 = u.pn * 128 + wc * 32 + fq * 8;
        const int grp = 2 * u.pm + wr; const int ff2 = 2 * ff;
        unsigned hres[8][4];
#pragma unroll
        for (int n = 0; n < 2; ++n) {
            const int hc = hc0 + 4 * n;
            const f32x4 wg0 = *(const f32x4*)(cw + hc), wg1 = *(const f32x4*)(cw + ff2 + hc), wg2 = *(const f32x4*)(cw + 2 * ff2 + hc), bg = *(const f32x4*)(cb + hc);
            const f32x4 wv0 = *(const f32x4*)(cw + ff + hc), wv1 = *(const f32x4*)(cw + ff2 + ff + hc), wv2 = *(const f32x4*)(cw + 2 * ff2 + ff + hc), bv = *(const f32x4*)(cb + ff + hc);
            {
                const bool lo = fr == 0;
                const f32x4 e0 = lo ? acc[0][0][0][n] : acc[1][0][2][n], e1 = lo ? acc[0][1][0][n] : acc[1][1][2][n], e2 = lo ? acc[0][0][1][n] : acc[1][0][3][n], e3 = lo ? acc[0][1][1][n] : acc[1][1][3][n];
                if (fr == 0 || fr == 15) { float* sb = SB + ((size_t)grp * 4 + (lo ? 0 : 2)) * ff2 + hc; *(f32x4*)(sb) = e0; *(f32x4*)(sb + ff) = e1; *(f32x4*)(sb + ff2) = e2; *(f32x4*)(sb + ff2 + ff) = e3; }
            }
            float hv[8][4];
#pragma unroll
            for (int j = 0; j < 4; ++j) {
                float gq[8], vq[8];
#pragma unroll
                for (int i = 0; i < 8; ++i) { gq[i] = acc[i >> 2][0][i & 3][n][j]; vq[i] = acc[i >> 2][1][i & 3][n][j]; }
                const float pg1 = dppf<0x111>(gq[7]), pg2 = dppf<0x111>(gq[6]), pv1 = dppf<0x111>(vq[7]), pv2 = dppf<0x111>(vq[6]);
#pragma unroll
                for (int i = 0; i < 8; ++i) {
                    const float g1 = i >= 1 ? gq[i >= 1 ? i - 1 : 0] : pg1, g2 = i >= 2 ? gq[i >= 2 ? i - 2 : 0] : (i == 1 ? pg1 : pg2);
                    const float v1 = i >= 1 ? vq[i >= 1 ? i - 1 : 0] : pv1, v2 = i >= 2 ? vq[i >= 2 ? i - 2 : 0] : (i == 1 ? pv1 : pv2);
                    const float cg = bg[j] + wg2[j] * gq[i] + wg1[j] * g1 + wg0[j] * g2;
                    const float cv = bv[j] + wv2[j] * vq[i] + wv1[j] * v1 + wv0[j] * v2;
                    hv[i][j] = cg * cv * __builtin_amdgcn_rcpf(1.0f + __expf(-cg));
                }
            }
#pragma unroll
            for (int i = 0; i < 8; ++i) { hres[i][2 * n] = cvt_pk_bf16(hv[i][0], hv[i][1]); hres[i][2 * n + 1] = cvt_pk_bf16(hv[i][2], hv[i][3]); }
        }
#pragma unroll
        for (int i = 0; i < 8; ++i) { u32x4 w; w.x = hres[i][0]; w.y = hres[i][1]; w.z = hres[i][2]; w.w = hres[i][3]; *(u32x4*)(Hout + (size_t)(tb + i) * ff + hc0) = w; }
    }
};

struct EpiLruIn {
    static constexpr bool PERM = true, AFTER_DRAIN = false, TOKPERM = true;
    bf16_t* GG; bf16_t* XBC; const float* cw; const float* cb; float* SB;
    __device__ __forceinline__ void operator()(const f32x4 (&acc)[2][2][4][2], const Unit& u, int wr, int wc, int fr, int fq) const {
        const int tb = u.pm * BM + wr * 128 + fr * 8;
        if (u.pn < 16) {
            const int col0 = u.pn * BM + wc * 32 + fq * 8;
#pragma unroll
            for (int i = 0; i < 8; ++i)
#pragma unroll
                for (int bj = 0; bj < 2; ++bj) { float f[8];
#pragma unroll
                    for (int e = 0; e < 8; ++e) { const float x = acc[i >> 2][bj][i & 3][e >> 2][e & 3];
                        const float z = 1.5957691216057308f * (x + 0.044715f * x * x * x); f[e] = x * __builtin_amdgcn_rcpf(1.0f + __expf(-z)); }
                    u32x4 w; w.x = cvt_pk_bf16(f[0], f[1]); w.y = cvt_pk_bf16(f[2], f[3]); w.z = cvt_pk_bf16(f[4], f[5]); w.w = cvt_pk_bf16(f[6], f[7]);
                    *(u32x4*)(GG + (size_t)(tb + i) * 4096 + col0 + bj * HALF) = w; }
        } else {
            const int c0 = (u.pn - 16) * BM + wc * 32 + fq * 8; const int grp = 2 * u.pm + wr;
#pragma unroll
            for (int bj = 0; bj < 2; ++bj) {
                unsigned hres[8][4];
#pragma unroll
                for (int n = 0; n < 2; ++n) {
                    const int c = c0 + bj * HALF + 4 * n;
                    const f32x4 w0 = *(const f32x4*)(cw + c), w1 = *(const f32x4*)(cw + 4096 + c), w2 = *(const f32x4*)(cw + 2 * 4096 + c), w3 = *(const f32x4*)(cw + 3 * 4096 + c), bb = *(const f32x4*)(cb + c);
                    {   const bool lo = fr == 0;
                        const f32x4 e0 = lo ? acc[0][bj][0][n] : acc[1][bj][1][n], e1 = lo ? acc[0][bj][1][n] : acc[1][bj][2][n], e2 = lo ? acc[0][bj][2][n] : acc[1][bj][3][n];
                        if (fr == 0 || fr == 15) { float* sb = SB + ((size_t)grp * 6 + (lo ? 0 : 3)) * 4096 + c; *(f32x4*)(sb) = e0; *(f32x4*)(sb + 4096) = e1; *(f32x4*)(sb + 2 * 4096) = e2; } }
                    float hv[8][4];
#pragma unroll
                    for (int j = 0; j < 4; ++j) {
                        float xq[8];
#pragma unroll
                        for (int i = 0; i < 8; ++i) xq[i] = acc[i >> 2][bj][i & 3][n][j];
                        const float p1 = dppf<0x111>(xq[7]), p2 = dppf<0x111>(xq[6]), p3 = dppf<0x111>(xq[5]);
#pragma unroll
                        for (int i = 0; i < 8; ++i) {
                            const float x1 = i >= 1 ? xq[i >= 1 ? i - 1 : 0] : p1;
                            const float x2 = i >= 2 ? xq[i >= 2 ? i - 2 : 0] : (i == 1 ? p1 : p2);
                            const float x3 = i >= 3 ? xq[i >= 3 ? i - 3 : 0] : (i == 2 ? p1 : (i == 1 ? p2 : p3));
                            hv[i][j] = bb[j] + w3[j] * xq[i] + w2[j] * x1 + w1[j] * x2 + w0[j] * x3;
                        }
                    }
#pragma unroll
                    for (int i = 0; i < 8; ++i) { hres[i][2 * n] = cvt_pk_bf16(hv[i][0], hv[i][1]); hres[i][2 * n + 1] = cvt_pk_bf16(hv[i][2], hv[i][3]); }
                }
#pragma unroll
                for (int i = 0; i < 8; ++i) { u32x4 w; w.x = hres[i][0]; w.y = hres[i][1]; w.z = hres[i][2]; w.w = hres[i][3]; *(u32x4*)(XBC + (size_t)(tb + i) * 4096 + c0 + bj * HALF) = w; }
            }
        }
    }
};

struct ChainOrder {
    int G, c;
    __device__ __forceinline__ bool next(int i, Unit& u) const { const int chain = c + (i >> 3) * G; if (chain >= 256) return false; u.pm = 8 * (chain >> 5) + (i & 7); u.pn = chain & 31; return true; }
    __device__ __forceinline__ void a_ready(const Unit&) const {}
    __device__ __forceinline__ void done(const Unit&) const {}
};
template <int CTRL> __device__ __forceinline__ float dpp_keep(float oldv, float v) { return __builtin_bit_cast(float, __builtin_amdgcn_update_dpp(__builtin_bit_cast(int, oldv), __builtin_bit_cast(int, v), CTRL, 0xF, 0xF, false)); }
struct EpiLruScan {
    static constexpr bool PERM = true, AFTER_DRAIN = false, TOKPERM = true;
    const bf16_t* XBC; const bf16_t* GG; bf16_t* Y; const float* rbias; const float* ibias; const float* lam; PG8_LAS float* X;
    __device__ __forceinline__ void operator()(const f32x4 (&acc)[2][2][4][2], const Unit& u, int wr, int wc, int fr, int fq) const {
        const int tb = u.pm * BM + wr * 128 + fr * 8;
        const int chl = wc * 32 + fq * 8, ch = (u.pn >> 1) * 256 + (u.pn & 1) * 128 + chl;
        const int jt = u.pm & 7; const bool t0lane = (jt == 0) && (wr == 0) && (fr == 0);
        float Av[8][8], Uv[8][8];
#pragma unroll
        for (int n = 0; n < 2; ++n) {
            const f32x4 rb = *(const f32x4*)(rbias + ch + 4 * n), ib = *(const f32x4*)(ibias + ch + 4 * n), lm = *(const f32x4*)(lam + ch + 4 * n);
            f32x4 sl;
#pragma unroll
            for (int j = 0; j < 4; ++j) { const float nl = -lm[j]; sl[j] = 8.0f * (fmaxf(nl, 0.f) + __logf(1.0f + __expf(-fabsf(nl)))); }
#pragma unroll
            for (int i = 0; i < 8; ++i) {
                const unsigned long long xw = *(const unsigned long long*)(XBC + (size_t)(tb + i) * 4096 + ch + 4 * n);
                const unsigned xl = (unsigned)xw, xh = (unsigned)(xw >> 32);
                const f32x4 xv = (f32x4){__uint_as_float(xl << 16), __uint_as_float(xl & 0xffff0000u), __uint_as_float(xh << 16), __uint_as_float(xh & 0xffff0000u)};
#pragma unroll
                for (int j = 0; j < 4; ++j) {
                    const int c = 4 * n + j;
                    const float rp = acc[i >> 2][0][i & 3][n][j] + rb[j], ip = acc[i >> 2][1][i & 3][n][j] + ib[j];
                    const float rg = __builtin_amdgcn_rcpf(1.0f + __expf(-rp)), ig = __builtin_amdgcn_rcpf(1.0f + __expf(-ip));
                    const float la = -rg * sl[j], a = __expf(la), x2 = la + la;
                    const float poly = -x2 * (1.0f + x2 * (0.5f + x2 * (0.16666667f + x2 * (0.041666668f + x2 * 0.0083333338f))));
                    const float em = x2 > -0.3f ? poly : 1.0f - a * a;
                    float mult = __builtin_amdgcn_sqrtf(em); if (t0lane && i == 0) mult = 1.0f;
                    Av[i][c] = a; Uv[i][c] = mult * ig * xv[j];
                }
                __builtin_amdgcn_sched_barrier(0);
            }
        }
        __builtin_amdgcn_sched_barrier(0);
        float Pex[8], Hex[8];
#pragma unroll
        for (int c = 0; c < 8; ++c) {
#pragma unroll
            for (int i = 1; i < 8; ++i) { Uv[i][c] = Av[i][c] * Uv[i - 1][c] + Uv[i][c]; Av[i][c] = Av[i][c] * Av[i - 1][c]; }
            float P = Av[7][c], H = Uv[7][c];
            { const float pp = dpp_keep<0x111>(1.0f, P), hh = dpp_keep<0x111>(0.0f, H); H = P * hh + H; P = P * pp; }
            { const float pp = dpp_keep<0x112>(1.0f, P), hh = dpp_keep<0x112>(0.0f, H); H = P * hh + H; P = P * pp; }
            { const float pp = dpp_keep<0x114>(1.0f, P), hh = dpp_keep<0x114>(0.0f, H); H = P * hh + H; P = P * pp; }
            { const float pp = dpp_keep<0x118>(1.0f, P), hh = dpp_keep<0x118>(0.0f, H); H = P * hh + H; P = P * pp; }
            Pex[c] = dpp_keep<0x111>(1.0f, P); Hex[c] = dpp_keep<0x111>(0.0f, H);
            if (wr == 0 && fr == 15) { X[(chl + c) * 2] = P; X[(chl + c) * 2 + 1] = H; }
            __builtin_amdgcn_sched_barrier(0);
        }
        asm volatile("s_waitcnt lgkmcnt(0)" ::: "memory"); __builtin_amdgcn_s_barrier(); asm volatile("" ::: "memory");
        PG8_LAS float* CARr = X + 256 + ((jt & 1) ^ 1) * 256; PG8_LAS float* CARw = X + 256 + (jt & 1) * 256;
#pragma unroll
        for (int c = 0; c < 8; ++c) {
            const float car = jt == 0 ? 0.0f : CARr[(chl + c) * 2];
            const float w0P = X[(chl + c) * 2], w0H = X[(chl + c) * 2 + 1];
            const float cwv = wr ? (w0P * car + w0H) : car;
            const float lc = Pex[c] * cwv + Hex[c];
#pragma unroll
            for (int i = 0; i < 8; ++i) Uv[i][c] = Uv[i][c] + Av[i][c] * lc;
            if (wr == 1 && fr == 15) CARw[(chl + c) * 2] = Uv[7][c];
            __builtin_amdgcn_sched_barrier(0);
        }
#pragma unroll
        for (int i = 0; i < 8; ++i) {
            const u32x4 gw = *(const u32x4*)(GG + (size_t)(tb + i) * 4096 + ch);
            float gv[8]; gv[0] = __uint_as_float(gw.x << 16); gv[1] = __uint_as_float(gw.x & 0xffff0000u); gv[2] = __uint_as_float(gw.y << 16); gv[3] = __uint_as_float(gw.y & 0xffff0000u);
            gv[4] = __uint_as_float(gw.z << 16); gv[5] = __uint_as_float(gw.z & 0xffff0000u); gv[6] = __uint_as_float(gw.w << 16); gv[7] = __uint_as_float(gw.w & 0xffff0000u);
            u32x4 w; w.x = cvt_pk_bf16(Uv[i][0] * gv[0], Uv[i][1] * gv[1]); w.y = cvt_pk_bf16(Uv[i][2] * gv[2], Uv[i][3] * gv[3]); w.z = cvt_pk_bf16(Uv[i][4] * gv[4], Uv[i][5] * gv[5]); w.w = cvt_pk_bf16(Uv[i][6] * gv[6], Uv[i][7] * gv[7]);
            *(u32x4*)(Y + (size_t)(tb + i) * 4096 + ch) = w;
            if (i & 1) __builtin_amdgcn_sched_barrier(0);
        }
    }
};

template <class Epi, class Sched, bool ALIGN_EPI = false, bool SP2 = false>
__device__ __forceinline__ void gemm_phase(PG8_LAS unsigned char* lds, const Gemm g, const Sched& S, const Epi& E) {
    const int tid = threadIdx.x, wid = __builtin_amdgcn_readfirstlane(tid >> 6), lane = tid & 63, wr = wid >> 2, wc = wid & 3, fr = lane & 15, fq = lane >> 4;
    const int K = g.K, nt = K / BK;
    unsigned voffA[2], voffB[2];
#pragma unroll
    for (int i = 0; i < 2; ++i) { int R, C; stage_rc(tid * 16 + i * 8192, R, C); const int Rb = Epi::PERM ? ((R & ~31) + perm32(R & 31)) : R;
        const int Ra = Epi::TOKPERM ? (128 * (R >> 6) + 8 * (R & 15) + ((R >> 4) & 3)) : R;
        voffA[i] = (unsigned)(Ra * g.lda + C) * 2u; voffB[i] = (unsigned)(Rb * K + C) * 2u; }
    const size_t kstep = (size_t)(BK * 2);
    const size_t hstepA = (size_t)(Epi::TOKPERM ? 4 : HALF) * g.lda * 2, hstepB = (size_t)HALF * K * 2;
    const size_t tstepA = (size_t)BM * g.lda * 2, tstepB = 2 * hstepB;
    const unsigned ldsw = (unsigned)wid * 1024u;
    const int aoff = lds_byte(wr * 64 + fr, fq * 8), boff = lds_byte(wc * 32 + fr, fq * 8);
#define PG8_ABASE(u) ((const char*)g.A + (size_t)(u).pm * tstepA + (g.a_mod ? (size_t)(((u).pn >> g.a_shift) % g.a_mod) * g.a_stride * 2 : (size_t)0))
#define PG8_SA(b, h) (((b) * 2 + (h)) * HTB)
#define PG8_SB(b, h) ((4 + (b) * 2 + (h)) * HTB)
#define PG8_STAGE(bufoff, gbase, voff) do { _Pragma("unroll") for (int _i = 0; _i < 2; ++_i) \
        __builtin_amdgcn_global_load_lds((const unsigned*)((const char*)(gbase) + (voff)[_i]), (PG8_LAS unsigned*)(lds + (bufoff) + ldsw + _i * 8192), 16, 0, 0); } while (0)
#define PG8_LDA(dst, b, h) do { _Pragma("unroll") for (int m = 0; m < 4; ++m) _Pragma("unroll") for (int k = 0; k < 2; ++k) dst[m][k] = *(const PG8_LAS bf16x8*)(lds + PG8_SA(b, h) + aoff + m * 2048 + k * 1024); } while (0)
#define PG8_LDB(dst, b, h) do { _Pragma("unroll") for (int n = 0; n < 2; ++n) _Pragma("unroll") for (int k = 0; k < 2; ++k) dst[n][k] = *(const PG8_LAS bf16x8*)(lds + PG8_SB(b, h) + boff + n * 2048 + k * 1024); } while (0)
#define PG8_MMA(ai, bj, At, Bt) do { __builtin_amdgcn_s_setprio(1); _Pragma("unroll") for (int m = 0; m < 4; ++m) _Pragma("unroll") for (int n = 0; n < 2; ++n) _Pragma("unroll") for (int k = 0; k < 2; ++k) \
        acc[ai][bj][m][n] = __builtin_amdgcn_mfma_f32_16x16x32_bf16(Bt[n][k], At[m][k], acc[ai][bj][m][n], 0, 0, 0); __builtin_amdgcn_s_setprio(0); } while (0)
#define PG8_WAIT_V(n) asm volatile("s_waitcnt vmcnt(" #n ")" ::: "memory")
#define PG8_WAIT_L(n) asm volatile("s_waitcnt lgkmcnt(" #n ")" ::: "memory")
#define PG8_BAR __builtin_amdgcn_s_barrier()
#define PG8_SCHED __builtin_amdgcn_sched_barrier(0)
    Unit cur, nxt; int ui = 0;
    if (!S.next(0, cur)) return;
    f32x4 acc[2][2][4][2];
#pragma unroll
    for (int a = 0; a < 2; ++a)
#pragma unroll
        for (int b = 0; b < 2; ++b)
#pragma unroll
            for (int m = 0; m < 4; ++m)
#pragma unroll
                for (int n = 0; n < 2; ++n) acc[a][b][m][n] = (f32x4){0.f, 0.f, 0.f, 0.f};
    bf16x8 At[4][2], B0[2][2], B1[2][2];
    const char* cA = PG8_ABASE(cur); const char* cB = (const char*)g.Bt + (size_t)cur.pn * tstepB;
    S.a_ready(cur);
    if constexpr (SP2) {
        PG8_STAGE(PG8_SB(0, 0), cB, voffB); PG8_STAGE(PG8_SB(0, 1), cB + hstepB, voffB); PG8_STAGE(PG8_SA(0, 0), cA, voffA); PG8_STAGE(PG8_SA(0, 1), cA + hstepA, voffA);
        if (wr == 1) PG8_BAR;
        PG8_WAIT_V(2); PG8_BAR;
        PG8_STAGE(PG8_SB(1, 0), cB + kstep, voffB); PG8_STAGE(PG8_SA(1, 0), cA + kstep, voffA); PG8_STAGE(PG8_SB(1, 1), cB + hstepB + kstep, voffB);
        PG8_WAIT_V(6); PG8_BAR;
    } else {
        PG8_STAGE(PG8_SB(0, 0), cB, voffB); PG8_STAGE(PG8_SA(0, 0), cA, voffA); PG8_STAGE(PG8_SB(0, 1), cB + hstepB, voffB); PG8_STAGE(PG8_SA(0, 1), cA + hstepA, voffA);
        if (wr == 1) PG8_BAR;
        PG8_WAIT_V(4); PG8_BAR;
        PG8_STAGE(PG8_SB(1, 0), cB + kstep, voffB); PG8_STAGE(PG8_SA(1, 0), cA + kstep, voffA); PG8_STAGE(PG8_SB(1, 1), cB + hstepB + kstep, voffB);
        PG8_WAIT_V(6); PG8_BAR;
    }
    for (;;) {
        const bool has_next = S.next(ui + 1, nxt);
        const char* nA = has_next ? PG8_ABASE(nxt) : cA; const char* nB = has_next ? (const char*)g.Bt + (size_t)nxt.pn * tstepB : cB;
#pragma unroll 1
        for (int t = 0; t < nt; t += 2) {
            const bool last = (t == nt - 2);
            const char* a1 = cA + (size_t)(t + 1) * kstep;
            const char* a2 = last ? nA : cA + (size_t)(t + 2) * kstep; const char* b2 = last ? nB : cB + (size_t)(t + 2) * kstep;
            const char* a3 = a2 + kstep; const char* b3 = b2 + kstep;
            if (last && has_next) S.a_ready(nxt);
            if constexpr (SP2) {
            PG8_LDB(B0, 0, 0); PG8_LDB(B1, 0, 1); PG8_SCHED; PG8_LDA(At, 0, 0); PG8_STAGE(PG8_SA(1, 1), a1 + hstepA, voffA);
            PG8_WAIT_V(8); PG8_WAIT_L(0); PG8_BAR; PG8_MMA(0, 0, At, B0); PG8_MMA(0, 1, At, B1); PG8_BAR; PG8_SCHED;
            PG8_LDA(At, 0, 1); PG8_STAGE(PG8_SB(0, 0), b2, voffB); PG8_STAGE(PG8_SB(0, 1), b2 + hstepB, voffB); PG8_STAGE(PG8_SA(0, 0), a2, voffA);
            PG8_WAIT_V(8); PG8_WAIT_L(0); PG8_BAR; PG8_MMA(1, 0, At, B0); PG8_MMA(1, 1, At, B1); PG8_BAR; PG8_SCHED;
            PG8_LDB(B0, 1, 0); PG8_LDB(B1, 1, 1); PG8_SCHED; PG8_LDA(At, 1, 0); PG8_STAGE(PG8_SA(0, 1), a2 + hstepA, voffA);
            PG8_WAIT_V(8); PG8_WAIT_L(0); PG8_BAR; PG8_MMA(0, 0, At, B0); PG8_MMA(0, 1, At, B1); PG8_BAR; PG8_SCHED;
            PG8_LDA(At, 1, 1); PG8_STAGE(PG8_SB(1, 0), b3, voffB); PG8_STAGE(PG8_SB(1, 1), b3 + hstepB, voffB); PG8_STAGE(PG8_SA(1, 0), a3, voffA);
            PG8_WAIT_V(8); PG8_WAIT_L(0); PG8_BAR; PG8_MMA(1, 0, At, B0); PG8_MMA(1, 1, At, B1); PG8_BAR; PG8_SCHED;
            } else {
            PG8_LDB(B0, 0, 0); PG8_SCHED; PG8_LDA(At, 0, 0); PG8_STAGE(PG8_SA(1, 1), a1 + hstepA, voffA);
            PG8_WAIT_L(8); PG8_BAR; PG8_WAIT_L(0); PG8_MMA(0, 0, At, B0); PG8_BAR; PG8_SCHED;
            PG8_LDB(B1, 0, 1); PG8_STAGE(PG8_SB(0, 0), b2, voffB);
            PG8_BAR; PG8_WAIT_L(0); PG8_MMA(0, 1, At, B1); PG8_BAR;
            PG8_LDA(At, 0, 1); PG8_STAGE(PG8_SA(0, 0), a2, voffA);
            PG8_BAR; PG8_WAIT_L(0); PG8_MMA(1, 0, At, B0); PG8_BAR; PG8_SCHED;
            PG8_STAGE(PG8_SB(0, 1), b2 + hstepB, voffB);
            PG8_WAIT_V(6); PG8_BAR; PG8_MMA(1, 1, At, B1); PG8_BAR;
            PG8_LDB(B0, 1, 0); PG8_SCHED; PG8_LDA(At, 1, 0); PG8_STAGE(PG8_SA(0, 1), a2 + hstepA, voffA);
            PG8_WAIT_L(8); PG8_BAR; PG8_WAIT_L(0); PG8_MMA(0, 0, At, B0); PG8_BAR; PG8_SCHED;
            PG8_LDB(B1, 1, 1); PG8_STAGE(PG8_SB(1, 0), b3, voffB);
            PG8_BAR; PG8_WAIT_L(0); PG8_MMA(0, 1, At, B1); PG8_BAR;
            PG8_LDA(At, 1, 1); PG8_STAGE(PG8_SA(1, 0), a3, voffA);
            PG8_BAR; PG8_WAIT_L(0); PG8_MMA(1, 0, At, B0); PG8_BAR; PG8_SCHED;
            PG8_STAGE(PG8_SB(1, 1), b3 + hstepB, voffB);
            PG8_WAIT_V(6); PG8_BAR; PG8_MMA(1, 1, At, B1); PG8_BAR;
            }
        }
        if constexpr (ALIGN_EPI) { if (wr == 0) PG8_BAR; }
        { int l2 = (int)__builtin_amdgcn_mbcnt_hi(~0u, __builtin_amdgcn_mbcnt_lo(~0u, 0u)); asm volatile("" : "+v"(l2));
          E(acc, cur, wr, wc, l2 & 15, l2 >> 4); } S.done(cur);
        if (!has_next) break;
#pragma unroll
        for (int a = 0; a < 2; ++a)
#pragma unroll
            for (int b = 0; b < 2; ++b)
#pragma unroll
                for (int m = 0; m < 4; ++m)
#pragma unroll
                    for (int n = 0; n < 2; ++n) acc[a][b][m][n] = (f32x4){0.f, 0.f, 0.f, 0.f};
        cur = nxt; cA = nA; cB = nB; ++ui;
        if constexpr (ALIGN_EPI) { if (wr == 1) PG8_BAR; }
    }
    PG8_WAIT_V(0);
    if constexpr (!ALIGN_EPI) { if (wr == 0) PG8_BAR; }
    PG8_BAR;
#undef PG8_ABASE
#undef PG8_SA
#undef PG8_SB
#undef PG8_STAGE
#undef PG8_LDA
#undef PG8_LDB
#undef PG8_MMA
#undef PG8_WAIT_V
#undef PG8_WAIT_L
#undef PG8_BAR
#undef PG8_SCHED
}
}

constexpr int NWAVES = 8, NTHR = 512;
constexpr int BATCH = 8, T = 2048, D = 4096, M = BATCH * T;
constexpr int RW = 2048, RPROJ = 6592, SPROJ = 6144, NIN0 = RPROJ + SPROJ  , NIN0P = 10752  , NVT0 = 10688  ;
constexpr int FF = 11008, FF2 = 22016;
constexpr int MH = M / 2;
constexpr float LN_EPS = 1e-5f, LNX_EPS = 64e-5f;
constexpr float DN_ALPHA = 1.41421356237309515f;

#ifndef MK_PER_PHASE
#define MK_PER_PHASE 0
#endif
constexpr int NPHASE = 22;
#ifndef PROBE_MASK
#define PROBE_MASK 0u
#endif

constexpr size_t MiB = 1u << 20;
constexpr size_t WS_CTL = 0, CTL_ZERO_BYTES = 64 * 1024;
constexpr size_t WS_WIN = 2 * MiB, WS_WOUT = 102 * MiB, WS_WUP = 134 * MiB, WS_WDOWN = 306 * MiB, WS_WL1 = 392 * MiB, WS_WG2 = 394 * MiB, WS_WGATES = 395 * MiB;
constexpr size_t WS_A0 = 400 * MiB;
constexpr size_t WS_BIG = 528 * MiB;
constexpr size_t WS_Y = 928 * MiB;
constexpr size_t WS_U = 1056 * MiB;
constexpr size_t WS_SB = 1400 * MiB;
constexpr size_t WS_W1P = 1444 * MiB;
constexpr size_t WS_END = 1734 * MiB;
constexpr int CW_BAR = 4096;

constexpr int RING_OFF = 0, RING_BYTES = 131072;
constexpr int LDSCTL_OFF = RING_BYTES, MISC_OFF = LDSCTL_OFF + 320;
constexpr int LDS_BYTES = 147456;

#define LAS __attribute__((address_space(3)))
typedef unsigned short bf16;
typedef unsigned v4u __attribute__((ext_vector_type(4)));
typedef unsigned v2u __attribute__((ext_vector_type(2)));
typedef float f32x4 __attribute__((ext_vector_type(4)));
#define RLX_AGENT __ATOMIC_RELAXED, __HIP_MEMORY_SCOPE_AGENT
__device__ __forceinline__ unsigned f2bf(float f) { unsigned u = __builtin_bit_cast(unsigned, f); return (u + 0x7fffu + ((u >> 16) & 1u)) >> 16; }
typedef float f32x2_t __attribute__((ext_vector_type(2)));
typedef __bf16 b16x2_t __attribute__((ext_vector_type(2)));
__device__ __forceinline__ unsigned pk2(float lo, float hi) { const f32x2_t v = {lo, hi}; return __builtin_bit_cast(unsigned, __builtin_convertvector(v, b16x2_t)); }
__device__ __forceinline__ float bflo(unsigned w) { return __uint_as_float(w << 16); }
__device__ __forceinline__ float bfhi(unsigned w) { return __uint_as_float(w & 0xffff0000u); }
__device__ __forceinline__ float sigmoidf_(float x) { return __builtin_amdgcn_rcpf(1.0f + __expf(-x)); }
__device__ __forceinline__ float softplusf_(float x) { return fmaxf(x, 0.f) + log1pf(__expf(-fabsf(x))); }

#define XB_TMO      128
#define XB_XCNT(j)  (256  + 64 * (j))
#define XB_XSUB(j)  (1280 + 64 * (j))
#define XB_XGEN(j)  (2304 + 64 * (j))
#define XB_TOP      3328
#define XB_TOPGEN   3392
#define XCD_BAR_WORDS 3456
#define XB_SPIN_CAP (1u << 23)

__device__ __forceinline__ unsigned xb_ld(unsigned* p)              { return __hip_atomic_load(p, __ATOMIC_RELAXED, __HIP_MEMORY_SCOPE_AGENT); }
__device__ __forceinline__ unsigned xb_add(unsigned* p, unsigned v) { return __hip_atomic_fetch_add(p, v, __ATOMIC_RELAXED, __HIP_MEMORY_SCOPE_AGENT); }
__device__ __forceinline__ unsigned xb_xcc_id() { return (unsigned)__builtin_amdgcn_s_getreg((3 << 11) | 20) & 0xFu; }
#define XB_SPIN(cond, bar) do { unsigned _sp = 0; while (cond) { __builtin_amdgcn_s_sleep(1); \
    if ((++_sp & 255u) == 0u) { if (xb_ld(&(bar)[XB_TMO])) break; if (_sp > XB_SPIN_CAP) { atomicAdd(&(bar)[XB_TMO], 1u); break; } } } } while (0)

struct XcdBarrier {
    unsigned* bar; unsigned x;
    volatile LAS unsigned* st;
};
__device__ __forceinline__ XcdBarrier xcd_barrier_post(unsigned* bar, volatile LAS unsigned* st) {
    XcdBarrier b; b.bar = bar; b.x = xb_xcc_id(); b.st = st;
    if (threadIdx.x == 0) (void)xb_add(&bar[XB_XCNT(b.x)], 1u);
    return b;
}
__device__ __forceinline__ void xcd_barrier_complete(unsigned* bar, unsigned x, unsigned& nloc, unsigned& nx) {
    const unsigned G = gridDim.x * gridDim.y * gridDim.z;
    unsigned sum, cnt, mine, sp = 0u;
    for (;;) {
        sum = 0u; cnt = 0u; mine = 0u;
#pragma unroll
        for (unsigned j = 0; j < 16; ++j) { const unsigned c = xb_ld(&bar[XB_XCNT(j)]); sum += c; cnt += (c > 0u) ? 1u : 0u; mine = (j == x) ? c : mine; }
        if (sum == G) break;
        __builtin_amdgcn_s_sleep(1);
        if ((++sp & 255u) == 0u) { if (xb_ld(&bar[XB_TMO])) break; if (sp > XB_SPIN_CAP) { atomicAdd(&bar[XB_TMO], 1u); break; } }
    }
    nloc = mine > 0u ? mine : 1u; nx = cnt > 0u ? cnt : 1u;
}
__device__ __forceinline__ void xcd_barrier(const XcdBarrier& b) {
    asm volatile("s_waitcnt vmcnt(0)" ::: "memory");
    __syncthreads();
    if (threadIdx.x == 0) {
        unsigned* bar = b.bar;
        __builtin_amdgcn_s_waitcnt(0);
        unsigned nloc = b.st[0], nx = b.st[1];
        if (nloc == 0u) { xcd_barrier_complete(bar, b.x, nloc, nx); b.st[0] = nloc; b.st[1] = nx; }
        const unsigned old = xb_add(&bar[XB_XSUB(b.x)], 1u);
        const unsigned gen = old / nloc;
        if (old + 1u == (gen + 1u) * nloc) {
            __builtin_amdgcn_fence(__ATOMIC_RELEASE, "agent");
            asm volatile("s_waitcnt vmcnt(0)" ::: "memory");
            const unsigned og = xb_add(&bar[XB_TOP], 1u);
            const unsigned tg = og / nx;
            if (og + 1u == (tg + 1u) * nx) xb_add(&bar[XB_TOPGEN], 1u);
            else XB_SPIN(xb_ld(&bar[XB_TOPGEN]) == tg, bar);
            __builtin_amdgcn_fence(__ATOMIC_ACQUIRE, "agent");
            xb_add(&bar[XB_XGEN(b.x)], 1u);
            asm volatile("s_waitcnt vmcnt(0)" ::: "memory");
        } else {
            XB_SPIN(xb_ld(&bar[XB_XGEN(b.x)]) == gen, bar);
            __builtin_amdgcn_fence(__ATOMIC_ACQUIRE, "agent");
            asm volatile("s_waitcnt vmcnt(0)" ::: "memory");
        }
    }
    __syncthreads();
}

#define LB_BASE   8192
#define LB_CNT(c) (LB_BASE + 64 * (c))
#define LB_GEN(c) (LB_BASE + 1024 + 64 * (c))
#define LB_MAP(c) (LB_BASE + 2048 + 64 * (c))
__device__ __forceinline__ void xcd_local_barrier(unsigned* ctl, unsigned* bar, int chunk, unsigned nloc) {
    asm volatile("s_waitcnt vmcnt(0)" ::: "memory");
    __syncthreads();
    if (threadIdx.x == 0) {
        const unsigned old = xb_add(&ctl[LB_CNT(chunk)], 1u);
        const unsigned gen = old / nloc;
        if (old + 1u == (gen + 1u) * nloc) xb_add(&ctl[LB_GEN(chunk)], 1u);
        else XB_SPIN(xb_ld(&ctl[LB_GEN(chunk)]) == gen, bar);
        __builtin_amdgcn_fence(__ATOMIC_ACQUIRE, "agent");
        asm volatile("s_waitcnt vmcnt(0)" ::: "memory");
    }
    __syncthreads();
}

__device__ __forceinline__ void transpose_item(const float* W, int K, int N, bf16* WT, int row_off, LAS float* scr, int item, int lane) {
    const int nblk = N / 32, kb = item / nblk, nb = item % nblk, k0 = 64 * kb, n0 = 32 * nb;
#pragma unroll 8
    for (int i = 0; i < 32; ++i) { const int kk = 2 * i + (lane >> 5); scr[kk * 33 + (lane & 31)] = W[(size_t)(k0 + kk) * N + n0 + (lane & 31)]; }
    asm volatile("s_waitcnt lgkmcnt(0)" ::: "memory");
    const int c = lane & 7;
#pragma unroll
    for (int j = 0; j < 4; ++j) { const int n = (lane >> 3) + 8 * j; const LAS float* s = scr + (8 * c) * 33 + n;
        v4u o; o.x = pk2(s[0 * 33], s[1 * 33]); o.y = pk2(s[2 * 33], s[3 * 33]); o.z = pk2(s[4 * 33], s[5 * 33]); o.w = pk2(s[6 * 33], s[7 * 33]);
        *(v4u*)(WT + (size_t)(row_off + n0 + n) * K + k0 + 8 * c) = o; }
    asm volatile("s_waitcnt lgkmcnt(0)" ::: "memory");
}
__device__ __forceinline__ float wave_sum(float v) {
#pragma unroll
    for (int o = 1; o < 64; o <<= 1) v += __shfl_xor(v, o);
    return v;
}
template <int CTRL> __device__ __forceinline__ float dpp_x(float v) { return __builtin_bit_cast(float, __builtin_amdgcn_update_dpp(0, __builtin_bit_cast(int, v), CTRL, 0xF, 0xF, true)); }
__device__ __forceinline__ float wave_sum_fast(float v) {
    v += dpp_x<0xB1>(v); v += dpp_x<0x4E>(v); v += dpp_x<0x141>(v); v += dpp_x<0x140>(v);
    v += __shfl_xor(v, 16); v += __shfl_xor(v, 32);
    return v;
}
__device__ __forceinline__ void ln_load(f32x4 (&v)[16], const float* src, int lane) {
    const f32x4* xr = (const f32x4*)src + lane;
#pragma unroll
    for (int j = 0; j < 16; ++j) v[j] = xr[64 * j];
}
__device__ __forceinline__ void ln_finish(f32x4 (&v)[16], const float* g, const float* bta, float* dstf, bf16* dstb, float* st, int lane) {
    float s = 0.f;
#pragma unroll
    for (int j = 0; j < 16; ++j) s += (v[j].x + v[j].y) + (v[j].z + v[j].w);
    const float mean = wave_sum_fast(s) * (1.f / D); float s2 = 0.f;
#pragma unroll
    for (int j = 0; j < 16; ++j) { v[j] = v[j] - mean; s2 += (v[j].x * v[j].x + v[j].y * v[j].y) + (v[j].z * v[j].z + v[j].w * v[j].w); }
    const float rstd = 1.f / sqrtf(wave_sum_fast(s2) * (1.f / D) + LN_EPS);
    if (st && lane == 0) { st[0] = mean; st[1] = rstd; }
#pragma unroll
    for (int j = 0; j < 16; ++j) {
        const f32x4 gg = ((const f32x4*)g)[lane + 64 * j], bb = ((const f32x4*)bta)[lane + 64 * j];
        const f32x4 o = v[j] * rstd * gg + bb;
        if (dstf) ((f32x4*)dstf)[lane + 64 * j] = o;
        if (dstb) { v2u w; w.x = pk2(o.x, o.y); w.y = pk2(o.z, o.w); ((v2u*)dstb)[lane + 64 * j] = w; }
    }
}
__device__ __forceinline__ void ln_load_b(f32x4 (&v)[16], const bf16* src, int lane) {
    const v4u* xr = (const v4u*)src + lane;
#pragma unroll
    for (int j = 0; j < 8; ++j) { const v4u w = xr[64 * j];
        v[2 * j] = (f32x4){bflo(w.x), bfhi(w.x), bflo(w.y), bfhi(w.y)}; v[2 * j + 1] = (f32x4){bflo(w.z), bfhi(w.z), bflo(w.w), bfhi(w.w)}; }
}
__device__ __forceinline__ void ln_finish_b(f32x4 (&v)[16], const float* g, const float* bta, bf16* dstb, float* st, int lane) {
    float s = 0.f;
#pragma unroll
    for (int j = 0; j < 16; ++j) s += (v[j].x + v[j].y) + (v[j].z + v[j].w);
    const float mean = wave_sum_fast(s) * (1.f / D); float s2 = 0.f;
#pragma unroll
    for (int j = 0; j < 16; ++j) { v[j] = v[j] - mean; s2 += (v[j].x * v[j].x + v[j].y * v[j].y) + (v[j].z * v[j].z + v[j].w * v[j].w); }
    const float rstd = 1.f / sqrtf(wave_sum_fast(s2) * (1.f / D) + LN_EPS);
    if (lane == 0) { st[0] = mean; st[1] = rstd; }
#pragma unroll
    for (int j = 0; j < 8; ++j) {
        const int c = 8 * (lane + 64 * j);
        const f32x4 ga = *(const f32x4*)(g + c), gb = *(const f32x4*)(g + c + 4), ba = *(const f32x4*)(bta + c), bb = *(const f32x4*)(bta + c + 4);
        const f32x4 oa = v[2 * j] * rstd * ga + ba, ob = v[2 * j + 1] * rstd * gb + bb;
        v4u w; w.x = pk2(oa.x, oa.y); w.y = pk2(oa.z, oa.w); w.z = pk2(ob.x, ob.y); w.w = pk2(ob.z, ob.w);
        ((v4u*)dstb)[lane + 64 * j] = w;
    }
}
__device__ __forceinline__ void ln_rows_b(const bf16* S, const float* g, const float* bta, bf16* dstb, float* st, int m0, int mstride, int mend, int lane) {
    f32x4 va[16], vb[16];
    int m = m0; if (m >= mend) return;
    ln_load_b(va, S + (size_t)m * D, lane);
    for (;;) {
        const int m2 = m + mstride;
        if (m2 < mend) ln_load_b(vb, S + (size_t)m2 * D, lane);
        ln_finish_b(va, g, bta, dstb + (size_t)m * D, st + 2 * (size_t)m, lane);
        if (m2 >= mend) break;
        const int m3 = m2 + mstride;
        if (m3 < mend) ln_load_b(va, S + (size_t)m3 * D, lane);
        ln_finish_b(vb, g, bta, dstb + (size_t)m2 * D, st + 2 * (size_t)m2, lane);
        if (m3 >= mend) break;
        m = m3;
    }
}
__device__ __forceinline__ void ln_finish_bf(f32x4 (&v)[16], const float* g, const float* bta, float* dstf, int lane) {
    float s = 0.f;
#pragma unroll
    for (int j = 0; j < 16; ++j) s += (v[j].x + v[j].y) + (v[j].z + v[j].w);
    const float mean = wave_sum_fast(s) * (1.f / D); float s2 = 0.f;
#pragma unroll
    for (int j = 0; j < 16; ++j) { v[j] = v[j] - mean; s2 += (v[j].x * v[j].x + v[j].y * v[j].y) + (v[j].z * v[j].z + v[j].w * v[j].w); }
    const float rstd = 1.f / sqrtf(wave_sum_fast(s2) * (1.f / D) + LN_EPS);
#pragma unroll
    for (int j = 0; j < 8; ++j) {
        const int c = 8 * (lane + 64 * j);
        const f32x4 ga = *(const f32x4*)(g + c), gb = *(const f32x4*)(g + c + 4), ba = *(const f32x4*)(bta + c), bb = *(const f32x4*)(bta + c + 4);
        __builtin_nontemporal_store(v[2 * j] * rstd * ga + ba, (f32x4*)(dstf + c)); __builtin_nontemporal_store(v[2 * j + 1] * rstd * gb + bb, (f32x4*)(dstf + c + 4));
    }
}
__device__ __forceinline__ void ln_rows_bf(const bf16* S, const float* g, const float* bta, float* dst, int m0, int mstride, int mend, int lane) {
    f32x4 va[16], vb[16];
    int m = m0; if (m >= mend) return;
    ln_load_b(va, S + (size_t)m * D, lane);
    for (;;) {
        const int m2 = m + mstride;
        if (m2 < mend) ln_load_b(vb, S + (size_t)m2 * D, lane);
        ln_finish_bf(va, g, bta, dst + (size_t)m * D, lane);
        if (m2 >= mend) break;
        const int m3 = m2 + mstride;
        if (m3 < mend) ln_load_b(va, S + (size_t)m3 * D, lane);
        ln_finish_bf(vb, g, bta, dst + (size_t)m2 * D, lane);
        if (m3 >= mend) break;
        m = m3;
    }
}
__device__ __forceinline__ void ln_rows(const float* S, const float* g, const float* bta, float* dstf, bf16* dstb, float* st, int m0, int mstride, int mend, int lane) {
    f32x4 va[16], vb[16];
    int m = m0; if (m >= mend) return;
    ln_load(va, S + (size_t)m * D, lane);
    for (;;) {
        const int m2 = m + mstride;
        if (m2 < mend) ln_load(vb, S + (size_t)m2 * D, lane);
        ln_finish(va, g, bta, dstf ? dstf + (size_t)m * D : nullptr, dstb ? dstb + (size_t)m * D : nullptr, st ? st + 2 * (size_t)m : nullptr, lane);
        if (m2 >= mend) break;
        const int m3 = m2 + mstride;
        if (m3 < mend) ln_load(va, S + (size_t)m3 * D, lane);
        ln_finish(vb, g, bta, dstf ? dstf + (size_t)m2 * D : nullptr, dstb ? dstb + (size_t)m2 * D : nullptr, st ? st + 2 * (size_t)m2 : nullptr, lane);
        if (m3 >= mend) break;
        m = m3;
    }
}
__device__ __forceinline__ void unpack8(const v4u w, float (&f)[8]) {
    f[0] = bflo(w.x); f[1] = bfhi(w.x); f[2] = bflo(w.y); f[3] = bfhi(w.y); f[4] = bflo(w.z); f[5] = bfhi(w.z); f[6] = bflo(w.w); f[7] = bfhi(w.w);
}
__device__ __forceinline__ v4u pack8(const float (&f)[8]) { v4u w; w.x = pk2(f[0], f[1]); w.y = pk2(f[2], f[3]); w.z = pk2(f[4], f[5]); w.w = pk2(f[6], f[7]); return w; }

struct Args { const float* in[39]; float* out; unsigned char* ws; int ph_lo, ph_hi; };


template <int CTRL> __device__ __forceinline__ float dpp_f(float v) { return __builtin_bit_cast(float, __builtin_amdgcn_update_dpp(0, __builtin_bit_cast(int, v), CTRL, 0xF, 0xF, true)); }
__device__ __forceinline__ float row16_sum(float v) {
    v += dpp_f<0xB1>(v);
    v += dpp_f<0x4E>(v);
    v += dpp_f<0x141>(v);
    v += dpp_f<0x140>(v);
    return v;
}


constexpr int CV_OUT = 64 * 64, CV_UP = 64 * 344, CV_DOWN = 172 * 64, CV_LAYER = CV_OUT + CV_UP + CV_DOWN, CV_FULL = 2 * CV_LAYER, CV_TOTAL = 2 * CV_FULL;
struct CvtDesc { const float* src; bf16* dst; int N, K; };
__device__ __forceinline__ CvtDesc cvt_desc(const Args& a, int hit, int lane) {
    const int it = hit >> 1, hf = hit & 1;
    const int L = it >= CV_LAYER; int r = it - L * CV_LAYER;
    unsigned char* wsb = a.ws;
    CvtDesc d;
    if (r < CV_OUT) { const int kb = r >> 6, nb = r & 63; d.N = D; d.K = D; d.src = (L ? a.in[30] : a.in[13]) + (size_t)(64 * kb) * D + 64 * nb + lane;
        d.dst = (bf16*)(wsb + (L ? WS_W1P : WS_WOUT)) + (size_t)(64 * nb + lane) * D + 64 * kb; d.src += (size_t)(32 * hf) * d.N; d.dst += 32 * hf; return d; }
    r -= CV_OUT;
    if (r < CV_UP) { const int kb = r / 344, nb = r - kb * 344, n0 = 64 * nb; const int row = n0 < FF ? 256 * (n0 >> 7) + (n0 & 127) : 256 * ((n0 - FF) >> 7) + 128 + ((n0 - FF) & 127);
        d.N = FF2; d.K = D; d.src = (L ? a.in[33] : a.in[16]) + (size_t)(64 * kb) * FF2 + n0 + lane;
        d.dst = (bf16*)(wsb + (L ? WS_W1P + 32 * MiB : WS_WUP)) + (size_t)(row + lane) * D + 64 * kb; d.src += (size_t)(32 * hf) * d.N; d.dst += 32 * hf; return d; }
    r -= CV_UP;
    { const int kb = r >> 6, nb = r & 63; d.N = D; d.K = FF; d.src = (L ? a.in[36] : a.in[19]) + (size_t)(64 * kb) * D + 64 * nb + lane;
      d.dst = (bf16*)(wsb + (L ? WS_W1P + 204 * MiB : WS_WDOWN)) + (size_t)(64 * nb + lane) * FF + 64 * kb; d.src += (size_t)(32 * hf) * d.N; d.dst += 32 * hf; return d; }
}
__device__ __forceinline__ void cvt_load(float (&v)[32], const CvtDesc& d) {
#pragma unroll
    for (int k = 0; k < 32; ++k) v[k] = d.src[(size_t)k * d.N];
}
__device__ __forceinline__ void cvt_store(const float (&v)[32], const CvtDesc& d) {
#pragma unroll
    for (int q = 0; q < 4; ++q) { v4u o; o.x = pk2(v[8 * q], v[8 * q + 1]); o.y = pk2(v[8 * q + 2], v[8 * q + 3]); o.z = pk2(v[8 * q + 4], v[8 * q + 5]); o.w = pk2(v[8 * q + 6], v[8 * q + 7]); ((v4u*)d.dst)[q] = o; }
}

__device__ __forceinline__ void row16_sum4(float& a, float& b, float& c, float& d) {
    asm volatile("s_nop 1\n\t"
        "v_add_f32_dpp %0, %0, %0 quad_perm:[1,0,3,2] row_mask:0xf bank_mask:0xf bound_ctrl:1\n\t"
        "v_add_f32_dpp %1, %1, %1 quad_perm:[1,0,3,2] row_mask:0xf bank_mask:0xf bound_ctrl:1\n\t"
        "v_add_f32_dpp %2, %2, %2 quad_perm:[1,0,3,2] row_mask:0xf bank_mask:0xf bound_ctrl:1\n\t"
        "v_add_f32_dpp %3, %3, %3 quad_perm:[1,0,3,2] row_mask:0xf bank_mask:0xf bound_ctrl:1\n\t"
        "v_add_f32_dpp %0, %0, %0 quad_perm:[2,3,0,1] row_mask:0xf bank_mask:0xf bound_ctrl:1\n\t"
        "v_add_f32_dpp %1, %1, %1 quad_perm:[2,3,0,1] row_mask:0xf bank_mask:0xf bound_ctrl:1\n\t"
        "v_add_f32_dpp %2, %2, %2 quad_perm:[2,3,0,1] row_mask:0xf bank_mask:0xf bound_ctrl:1\n\t"
        "v_add_f32_dpp %3, %3, %3 quad_perm:[2,3,0,1] row_mask:0xf bank_mask:0xf bound_ctrl:1\n\t"
        "v_add_f32_dpp %0, %0, %0 row_half_mirror row_mask:0xf bank_mask:0xf bound_ctrl:1\n\t"
        "v_add_f32_dpp %1, %1, %1 row_half_mirror row_mask:0xf bank_mask:0xf bound_ctrl:1\n\t"
        "v_add_f32_dpp %2, %2, %2 row_half_mirror row_mask:0xf bank_mask:0xf bound_ctrl:1\n\t"
        "v_add_f32_dpp %3, %3, %3 row_half_mirror row_mask:0xf bank_mask:0xf bound_ctrl:1\n\t"
        "v_add_f32_dpp %0, %0, %0 row_mirror row_mask:0xf bank_mask:0xf bound_ctrl:1\n\t"
        "v_add_f32_dpp %1, %1, %1 row_mirror row_mask:0xf bank_mask:0xf bound_ctrl:1\n\t"
        "v_add_f32_dpp %2, %2, %2 row_mirror row_mask:0xf bank_mask:0xf bound_ctrl:1\n\t"
        "v_add_f32_dpp %3, %3, %3 row_mirror row_mask:0xf bank_mask:0xf bound_ctrl:1\n\t"
        "s_nop 0"
        : "+v"(a), "+v"(b), "+v"(c), "+v"(d));
}
__device__ __forceinline__ void row8_sum4(float& a, float& b, float& c, float& d) {
    asm volatile("s_nop 1\n\t"
        "v_add_f32_dpp %0, %0, %0 quad_perm:[1,0,3,2] row_mask:0xf bank_mask:0xf bound_ctrl:1\n\t"
        "v_add_f32_dpp %1, %1, %1 quad_perm:[1,0,3,2] row_mask:0xf bank_mask:0xf bound_ctrl:1\n\t"
        "v_add_f32_dpp %2, %2, %2 quad_perm:[1,0,3,2] row_mask:0xf bank_mask:0xf bound_ctrl:1\n\t"
        "v_add_f32_dpp %3, %3, %3 quad_perm:[1,0,3,2] row_mask:0xf bank_mask:0xf bound_ctrl:1\n\t"
        "v_add_f32_dpp %0, %0, %0 quad_perm:[2,3,0,1] row_mask:0xf bank_mask:0xf bound_ctrl:1\n\t"
        "v_add_f32_dpp %1, %1, %1 quad_perm:[2,3,0,1] row_mask:0xf bank_mask:0xf bound_ctrl:1\n\t"
        "v_add_f32_dpp %2, %2, %2 quad_perm:[2,3,0,1] row_mask:0xf bank_mask:0xf bound_ctrl:1\n\t"
        "v_add_f32_dpp %3, %3, %3 quad_perm:[2,3,0,1] row_mask:0xf bank_mask:0xf bound_ctrl:1\n\t"
        "v_add_f32_dpp %0, %0, %0 row_half_mirror row_mask:0xf bank_mask:0xf bound_ctrl:1\n\t"
        "v_add_f32_dpp %1, %1, %1 row_half_mirror row_mask:0xf bank_mask:0xf bound_ctrl:1\n\t"
        "v_add_f32_dpp %2, %2, %2 row_half_mirror row_mask:0xf bank_mask:0xf bound_ctrl:1\n\t"
        "v_add_f32_dpp %3, %3, %3 row_half_mirror row_mask:0xf bank_mask:0xf bound_ctrl:1\n\t"
        "s_nop 0"
        : "+v"(a), "+v"(b), "+v"(c), "+v"(d));
}
constexpr int RCH = 16, RVEC = 5 * RCH * 64, RV1 = RCH * 64;
struct RwkvStepIn { f32x2_t kk[4], wr[4], w[4], b[4], k[4]; f32x2_t vv, sc; };
__device__ __forceinline__ void rwkv_ld(RwkvStepIn& x, const LAS float* VEC, const LAS float* VV, const LAS float* SC, int i, int kq, int vrow) {
    const LAS f32x4* q0 = (const LAS f32x4*)(VEC + i * 64 + 8 * kq);
    const f32x4 a0 = q0[0], a1 = q0[1], b0 = q0[RV1 / 4], b1 = q0[RV1 / 4 + 1], c0 = q0[2 * RV1 / 4], c1 = q0[2 * RV1 / 4 + 1], d0 = q0[3 * RV1 / 4], d1 = q0[3 * RV1 / 4 + 1], e0 = q0[4 * RV1 / 4], e1 = q0[4 * RV1 / 4 + 1];
    x.kk[0] = (f32x2_t){a0[0], a0[1]}; x.kk[1] = (f32x2_t){a0[2], a0[3]}; x.kk[2] = (f32x2_t){a1[0], a1[1]}; x.kk[3] = (f32x2_t){a1[2], a1[3]};
    x.wr[0] = (f32x2_t){b0[0], b0[1]}; x.wr[1] = (f32x2_t){b0[2], b0[3]}; x.wr[2] = (f32x2_t){b1[0], b1[1]}; x.wr[3] = (f32x2_t){b1[2], b1[3]};
    x.w[0] = (f32x2_t){c0[0], c0[1]}; x.w[1] = (f32x2_t){c0[2], c0[3]}; x.w[2] = (f32x2_t){c1[0], c1[1]}; x.w[3] = (f32x2_t){c1[2], c1[3]};
    x.b[0] = (f32x2_t){d0[0], d0[1]}; x.b[1] = (f32x2_t){d0[2], d0[3]}; x.b[2] = (f32x2_t){d1[0], d1[1]}; x.b[3] = (f32x2_t){d1[2], d1[3]};
    x.k[0] = (f32x2_t){e0[0], e0[1]}; x.k[1] = (f32x2_t){e0[2], e0[3]}; x.k[2] = (f32x2_t){e1[0], e1[1]}; x.k[3] = (f32x2_t){e1[2], e1[3]};
    x.vv = *(const LAS f32x2_t*)(VV + i * 64 + vrow); x.sc = *(const LAS f32x2_t*)(SC + 4 * i);
}
__device__ __forceinline__ void rwkv_step(const RwkvStepIn& x, f32x2_t (&s0)[4], f32x2_t (&s1)[4], LAS float* YY, int i, int kq, int vrow) {
    f32x2_t pa = s0[0] * x.kk[0], pb = s1[0] * x.kk[0], pc = s0[0] * x.wr[0], pd = s1[0] * x.wr[0];
#pragma unroll
    for (int q = 1; q < 4; ++q) { pa = s0[q] * x.kk[q] + pa; pb = s1[q] * x.kk[q] + pb; pc = s0[q] * x.wr[q] + pc; pd = s1[q] * x.wr[q] + pd; }
    float psa0 = pa[0] + pa[1], psa1 = pb[0] + pb[1], py0 = pc[0] + pc[1], py1 = pd[0] + pd[1];
    row8_sum4(psa0, psa1, py0, py1);
    const f32x2_t na0 = (f32x2_t){-psa0, -psa0}, na1 = (f32x2_t){-psa1, -psa1}, v0 = (f32x2_t){x.vv[0], x.vv[0]}, v1 = (f32x2_t){x.vv[1], x.vv[1]};
#pragma unroll
    for (int q = 0; q < 4; ++q) { s0[q] = s0[q] * x.w[q] + x.b[q] * na0 + x.k[q] * v0; s1[q] = s1[q] * x.w[q] + x.b[q] * na1 + x.k[q] * v1; }
    f32x2_t yo; yo[0] = py0 - psa0 * x.sc[0] + x.vv[0] * x.sc[1]; yo[1] = py1 - psa1 * x.sc[0] + x.vv[1] * x.sc[1];
    if (kq == 0) *(LAS f32x2_t*)(YY + i * 64 + vrow) = yo;
}
struct RwkvTok { v2u r1, k1, v1, r0, k0, v0, gw; f32x4 wpre, apre; };
__device__ __forceinline__ void rwkv_gld(RwkvTok& g, const bf16* p, const float* wa, const bf16* gbuf, size_t m, int t, int hc) {
    const bf16* prow = p + m * NIN0P + hc;
    g.r1 = *(const v2u*)(prow); g.k1 = *(const v2u*)(prow + 2048); g.v1 = *(const v2u*)(prow + 4096);
    g.r0 = (v2u){0u, 0u}; g.k0 = g.r0; g.v0 = g.r0;
    if (t > 0) { g.r0 = *(const v2u*)(prow - NIN0P); g.k0 = *(const v2u*)(prow - NIN0P + 2048); g.v0 = *(const v2u*)(prow - NIN0P + 4096); }
    g.wpre = *(const f32x4*)(wa + m * 4096 + hc); g.apre = *(const f32x4*)(wa + m * 4096 + 2048 + hc);
    g.gw = *(const v2u*)(gbuf + m * 2048 + hc);
}
struct RwkvPar { f32x4 mu_r, mu_k, mu_v, dbase, ibase, kkp, kap, rkp, lg, lb; };
__device__ __forceinline__ f32x4 rwkv_prep(const RwkvTok& g, const RwkvPar& P, LAS float* VEC, LAS float* VV, LAS float* SC, int tok, int cq) {
    const f32x4 rc = (f32x4){bflo(g.r1.x), bfhi(g.r1.x), bflo(g.r1.y), bfhi(g.r1.y)}, rpv = (f32x4){bflo(g.r0.x), bfhi(g.r0.x), bflo(g.r0.y), bfhi(g.r0.y)};
    const f32x4 kc = (f32x4){bflo(g.k1.x), bfhi(g.k1.x), bflo(g.k1.y), bfhi(g.k1.y)}, kp = (f32x4){bflo(g.k0.x), bfhi(g.k0.x), bflo(g.k0.y), bfhi(g.k0.y)};
    const f32x4 vc = (f32x4){bflo(g.v1.x), bfhi(g.v1.x), bflo(g.v1.y), bfhi(g.v1.y)}, vp = (f32x4){bflo(g.v0.x), bfhi(g.v0.x), bflo(g.v0.y), bfhi(g.v0.y)};
    const f32x4 rr = rc + (rpv - rc) * P.mu_r, kx = kc + (kp - kc) * P.mu_k, vx = vc + (vp - vc) * P.mu_v;
    f32x4 dec, av, kkr, k2; float ss = 0.f;
#pragma unroll
    for (int j = 0; j < 4; ++j) {
        const float zw = P.dbase[j] + g.wpre[j];
        dec[j] = __expf(-0.60653065971263342f * sigmoidf_(zw));
        av[j] = sigmoidf_(P.ibase[j] + g.apre[j]);
        kkr[j] = kx[j] * P.kkp[j]; ss += kkr[j] * kkr[j];
        k2[j] = kx[j] * (1.0f + (av[j] - 1.0f) * P.kap[j]);
    }
    ss = row16_sum(ss);
    const float inv = __builtin_amdgcn_rsqf(fmaxf(ss, 1e-24f));
    const f32x4 kkn = kkr * inv, bb = kkn * av, wr = dec * rr;
    float br = 0.f, kr = 0.f, bon = 0.f, dmy = 0.f;
#pragma unroll
    for (int j = 0; j < 4; ++j) { br += bb[j] * rr[j]; kr += k2[j] * rr[j]; bon += rr[j] * k2[j] * P.rkp[j]; }
    row16_sum4(br, kr, bon, dmy);
    const int o = tok * 64 + 4 * cq;
    *(LAS f32x4*)(VEC + 0 * RV1 + o) = kkn; *(LAS f32x4*)(VEC + 1 * RV1 + o) = wr; *(LAS f32x4*)(VEC + 2 * RV1 + o) = dec;
    *(LAS f32x4*)(VEC + 3 * RV1 + o) = bb;  *(LAS f32x4*)(VEC + 4 * RV1 + o) = k2; *(LAS f32x4*)(VV + o) = vx;
    if (cq == 0) *(LAS f32x2_t*)(SC + 4 * tok) = (f32x2_t){br, kr};
    return vx * bon;
}
__device__ __forceinline__ void rwkv_post(const LAS float* YY, const f32x4 pv, const v2u gw, const RwkvPar& P, bf16* yout, int tok, int cq) {
    const f32x4 y4 = *(const LAS f32x4*)(YY + tok * 64 + 4 * cq);
    float s1_ = (y4[0] + y4[1]) + (y4[2] + y4[3]);
    s1_ = row16_sum(s1_);
    const float mean = s1_ * (1.f / 64.f); const f32x4 d = y4 - mean;
    float s2 = (d[0] * d[0] + d[1] * d[1]) + (d[2] * d[2] + d[3] * d[3]);
    s2 = row16_sum(s2);
    const float rstd = __builtin_amdgcn_rsqf(s2 * (1.f / 64.f) + LNX_EPS);
    const f32x4 gv = (f32x4){bflo(gw.x), bfhi(gw.x), bflo(gw.y), bfhi(gw.y)};
    const f32x4 res = (d * rstd * P.lg + P.lb + pv) * gv;
    v2u ow; ow.x = pk2(res[0], res[1]); ow.y = pk2(res[2], res[3]);
    *(v2u*)(yout) = ow;
}
__device__ __forceinline__ void rwkv_head(const Args& a, LAS float* L, int bh, const bf16* p, const float* wa, const bf16* gbuf, bf16* Y, bool do_cvt, int cvt_j0) {
    const int tid = threadIdx.x, lane = tid & 63, w = __builtin_amdgcn_readfirstlane(tid >> 6);
    const int b = bh >> 5, h = bh & 31;
    LAS float* VEC = L; LAS float* VV = L + 2 * RVEC; LAS float* SC = VV + 2 * RV1; LAS float* YY = SC + 2 * RCH * 4;
    constexpr int NCH = T / RCH;
    if (w < 4) {
        const int rp = lane >> 3, kq = lane & 7, vrow = 16 * w + 2 * rp;
        f32x2_t s0[4], s1[4];
#pragma unroll
        for (int q = 0; q < 4; ++q) { s0[q] = (f32x2_t){0.f, 0.f}; s1[q] = s0[q]; }
        __syncthreads();
#pragma unroll 1
        for (int c = 0; c < NCH; ++c) {
            const LAS float* vec = VEC + (c & 1) * RVEC; const LAS float* vv = VV + (c & 1) * RV1; const LAS float* sc = SC + (c & 1) * RCH * 4; LAS float* yy = YY + (c & 1) * RV1;
            RwkvStepIn xa, xb;
            rwkv_ld(xa, vec, vv, sc, 0, kq, vrow);
#pragma unroll 1
            for (int i = 0; i < RCH; i += 2) {
                rwkv_ld(xb, vec, vv, sc, i + 1, kq, vrow);
                rwkv_step(xa, s0, s1, yy, i, kq, vrow);
                rwkv_ld(xa, vec, vv, sc, (i + 2) & (RCH - 1), kq, vrow);
                rwkv_step(xb, s0, s1, yy, i + 1, kq, vrow);
            }
            __syncthreads();
        }
    } else {
        const int at = tid - 256, tok = at >> 4, cq = at & 15, hc = h * 64 + 4 * cq;
        RwkvPar P;
        P.mu_r = *(const f32x4*)(a.in[2] + hc); P.mu_k = *(const f32x4*)(a.in[2] + 2048 + hc); P.mu_v = *(const f32x4*)(a.in[2] + 4096 + hc);
        P.dbase = *(const f32x4*)(a.in[3] + hc); P.ibase = *(const f32x4*)(a.in[5] + hc); P.kkp = *(const f32x4*)(a.in[8] + hc); P.kap = *(const f32x4*)(a.in[9] + hc);
        P.rkp = *(const f32x4*)(a.in[10] + hc); P.lg = *(const f32x4*)(a.in[11] + hc); P.lb = *(const f32x4*)(a.in[12] + hc);
        const size_t mb = (size_t)b * T + tok;
        RwkvTok g0, g1; rwkv_gld(g0, p, wa, gbuf, mb, tok, hc);
        f32x4 pvA = (f32x4){0.f, 0.f, 0.f, 0.f}, pvB = rwkv_prep(g0, P, VEC, VV, SC, tok, cq);
        v2u gwA = (v2u){0u, 0u}, gwB = g0.gw;
        rwkv_gld(g1, p, wa, gbuf, mb + RCH, tok + RCH, hc);
        rwkv_gld(g0, p, wa, gbuf, mb + 2 * RCH, tok + 2 * RCH, hc);
        const int aw = blockIdx.x * 4 + (w - 4), astride = gridDim.x * 4;
        float cvb[32]; int cpend = -1;
        __syncthreads();
#pragma unroll 1
        for (int c = 0; c < NCH; ++c) {
            if (do_cvt) {
                if (cpend >= 0) { const CvtDesc dd = cvt_desc(a, cpend, lane); cvt_store(cvb, dd); }
                const int itn = aw + (cvt_j0 + c) * astride;
                if (itn < CV_TOTAL) { const CvtDesc dd = cvt_desc(a, itn, lane); cvt_load(cvb, dd); cpend = itn; } else cpend = -1;
            }
            f32x4 pvN = pvB; v2u gwN = gwB;
            if (c + 1 < NCH) {
                const int bf = (c + 1) & 1;
                if (bf) { pvN = rwkv_prep(g1, P, VEC + RVEC, VV + RV1, SC + RCH * 4, tok, cq); gwN = g1.gw;
                          if (c + 3 < NCH) rwkv_gld(g1, p, wa, gbuf, mb + (size_t)(c + 3) * RCH, tok + (c + 3) * RCH, hc); }
                else    { pvN = rwkv_prep(g0, P, VEC, VV, SC, tok, cq); gwN = g0.gw;
                          if (c + 3 < NCH) rwkv_gld(g0, p, wa, gbuf, mb + (size_t)(c + 3) * RCH, tok + (c + 3) * RCH, hc); }
            }
            if (c >= 1) rwkv_post(YY + ((c - 1) & 1) * RV1, pvA, gwA, P, Y + (mb + (size_t)(c - 1) * RCH) * D + hc, tok, cq);
            pvA = pvB; gwA = gwB; pvB = pvN; gwB = gwN;
            __syncthreads();
        }
        rwkv_post(YY + ((NCH - 1) & 1) * RV1, pvA, gwA, P, Y + (mb + (size_t)(NCH - 1) * RCH) * D + hc, tok, cq);
        if (do_cvt && cpend >= 0) { const CvtDesc dd = cvt_desc(a, cpend, lane); cvt_store(cvb, dd); }
    }
    __syncthreads();
}

typedef short bf16x8_t __attribute__((ext_vector_type(8)));
typedef float f32x16_t __attribute__((ext_vector_type(16)));
__device__ __forceinline__ void sba_task(int task, const bf16* p, const bf16* VT, bf16* Y, int lane) {
    const int qb = task & 63, h = (task >> 6) & 31, b = task >> 11;
    const int n = lane & 31, hi = lane >> 5;
    const int t = 32 * qb + n; const size_t mq = (size_t)b * T + t;
    bf16x8_t qf[4];
#pragma unroll
    for (int s = 0; s < 4; ++s) { float f[8]; unpack8(*(const v4u*)(p + mq * NIN0P + RPROJ + h * 64 + 16 * s + 8 * hi), f);
#pragma unroll
        for (int e = 0; e < 8; ++e) f[e] *= 0.125f;
        qf[s] = __builtin_bit_cast(bf16x8_t, pack8(f)); }
    f32x16_t o0, o1;
#pragma unroll
    for (int r = 0; r < 16; ++r) { o0[r] = 0.f; o1[r] = 0.f; }
    float R = 1.f;
    const bf16* kbase = p + ((size_t)b * T + n) * NIN0P + RPROJ + 2048 + h * 64 + 8 * hi;
    const bf16* vbase = VT + (size_t)(h * 64 + n) * M + (size_t)b * T + 4 * hi;
    bf16x8_t kf[4]; v2u vf[2][2][2];
#define SBA_LOAD(k0_) do { _Pragma("unroll") for (int s = 0; s < 4; ++s) kf[s] = *(const bf16x8_t*)(kbase + (size_t)(k0_) * NIN0P + 16 * s); \
        _Pragma("unroll") for (int dh = 0; dh < 2; ++dh) _Pragma("unroll") for (int s = 0; s < 2; ++s) { const bf16* vp_ = vbase + (size_t)dh * 32 * M + (k0_) + 16 * s; vf[dh][s][0] = *(const v2u*)(vp_); vf[dh][s][1] = *(const v2u*)(vp_ + 8); } } while (0)
    SBA_LOAD(32 * qb);
    for (int kt = qb; kt >= 0; --kt) {
        f32x16_t z;
#pragma unroll
        for (int r = 0; r < 16; ++r) z[r] = 0.f;
#pragma unroll
        for (int s = 0; s < 4; ++s) z = __builtin_amdgcn_mfma_f32_32x32x16_bf16(kf[s], qf[s], z, 0, 0, 0);
        bf16x8_t va[2][2];
#pragma unroll
        for (int dh = 0; dh < 2; ++dh)
#pragma unroll
            for (int s = 0; s < 2; ++s) { v4u w_; w_.x = vf[dh][s][0].x; w_.y = vf[dh][s][0].y; w_.z = vf[dh][s][1].x; w_.w = vf[dh][s][1].y; va[dh][s] = __builtin_bit_cast(bf16x8_t, w_); }
        if (kt > 0) SBA_LOAD(32 * (kt - 1));
        const bool diag = (kt == qb);
        float kp[16], bt[16];
#pragma unroll
        for (int r = 0; r < 16; ++r) {
            const int key = (r & 3) + 8 * (r >> 2) + 4 * hi;
            const bool valid = !diag || key < n;
            const float kv = __builtin_amdgcn_rcpf(1.0f + __expf(z[r]));
            kp[r] = valid ? kv : 1.0f;
            bt[r] = valid ? 1.0f - kv : 0.0f;
        }
        float Gs[4], Gp[4];
#pragma unroll
        for (int g = 0; g < 4; ++g) { Gs[g] = (kp[4 * g] * kp[4 * g + 1]) * (kp[4 * g + 2] * kp[4 * g + 3]); Gp[g] = __shfl_xor(Gs[g], 32); }
        float base = R;
        f32x16_t pr;
#pragma unroll
        for (int g = 3; g >= 0; --g) {
            float c = base * (hi == 0 ? Gp[g] : 1.0f);
            pr[4 * g + 3] = bt[4 * g + 3] * c; c *= kp[4 * g + 3];
            pr[4 * g + 2] = bt[4 * g + 2] * c; c *= kp[4 * g + 2];
            pr[4 * g + 1] = bt[4 * g + 1] * c; c *= kp[4 * g + 1];
            pr[4 * g + 0] = bt[4 * g + 0] * c;
            base *= Gs[g] * Gp[g];
        }
        R = base;
#pragma unroll
        for (int s = 0; s < 2; ++s) {
            v4u pw; pw.x = pk2(pr[8 * s], pr[8 * s + 1]); pw.y = pk2(pr[8 * s + 2], pr[8 * s + 3]); pw.z = pk2(pr[8 * s + 4], pr[8 * s + 5]); pw.w = pk2(pr[8 * s + 6], pr[8 * s + 7]);
            const bf16x8_t pb = __builtin_bit_cast(bf16x8_t, pw);
            o0 = __builtin_amdgcn_mfma_f32_32x32x16_bf16(va[0][s], pb, o0, 0, 0, 0);
            o1 = __builtin_amdgcn_mfma_f32_32x32x16_bf16(va[1][s], pb, o1, 0, 0, 0);
        }
        if (__all(R < 1e-37f)) break;
    }
#undef SBA_LOAD
    bf16* orow = Y + mq * D + RW + h * 64 + 4 * hi;
#pragma unroll
    for (int g = 0; g < 4; ++g) {
        v2u w0; w0.x = pk2(o0[4 * g], o0[4 * g + 1]); w0.y = pk2(o0[4 * g + 2], o0[4 * g + 3]); *(v2u*)(orow + 8 * g) = w0;
        v2u w1; w1.x = pk2(o1[4 * g], o1[4 * g + 1]); w1.y = pk2(o1[4 * g + 2], o1[4 * g + 3]); *(v2u*)(orow + 32 + 8 * g) = w1;
    }
}

__device__ __forceinline__ void lru_elem(const float (&rp)[8], const float (&ip)[8], const float (&xv)[8], const float (&rb)[8], const float (&ib)[8], const float (&sl)[8], bool first, float (&av)[8], float (&uv)[8]) {
#pragma unroll
    for (int e = 0; e < 8; ++e) {
        const float rg = sigmoidf_(rp[e] + rb[e]), ig = sigmoidf_(ip[e] + ib[e]);
        const float la = -rg * sl[e]; av[e] = __expf(la);
        float mult = __builtin_amdgcn_sqrtf(-expm1f(2.0f * la)); if (first) mult = 1.0f;
        uv[e] = mult * ig * xv[e];
    }
}
__device__ __forceinline__ void lru_task(const Args& a, LAS float* L, int task, const bf16* RI, const bf16* xbc, const bf16* gg, bf16* Y) {
    const int tid = threadIdx.x, lane = tid & 63, w = tid >> 6;
    const int ts = lane >> 3, co = lane & 7;
    const int b = task >> 6, c = (task & 63) * 64 + co * 8;
    float rb[8], ib[8], sl[8];
#pragma unroll
    for (int e = 0; e < 8; ++e) { rb[e] = a.in[26][c + e]; ib[e] = a.in[28][c + e]; sl[e] = 8.0f * softplusf_(-a.in[29][c + e]); }
    const int t0 = 256 * w + 32 * ts; const size_t m0 = (size_t)b * T + t0;
    float P[8], H[8];
#pragma unroll
    for (int e = 0; e < 8; ++e) { P[e] = 1.f; H[e] = 0.f; }
#pragma unroll 2
    for (int i = 0; i < 32; ++i) {
        const size_t m = m0 + i;
        float rp[8], ip[8], xv[8], av[8], uv[8];
        unpack8(*(const v4u*)(RI + m * 8192 + c), rp); unpack8(*(const v4u*)(RI + m * 8192 + 4096 + c), ip); unpack8(*(const v4u*)(xbc + m * D + c), xv);
        lru_elem(rp, ip, xv, rb, ib, sl, (t0 + i) == 0, av, uv);
#pragma unroll
        for (int e = 0; e < 8; ++e) { H[e] = av[e] * H[e] + uv[e]; P[e] *= av[e]; }
    }
    float Pin[8], Hin[8];
#pragma unroll
    for (int e = 0; e < 8; ++e) { Pin[e] = P[e]; Hin[e] = H[e]; }
#pragma unroll
    for (int d = 8; d < 64; d <<= 1) {
#pragma unroll
        for (int e = 0; e < 8; ++e) { const float pp = __shfl_up(Pin[e], d), hh = __shfl_up(Hin[e], d); if (lane >= d) { Hin[e] = Pin[e] * hh + Hin[e]; Pin[e] = Pin[e] * pp; } }
    }
    float Pex[8], Hex[8];
#pragma unroll
    for (int e = 0; e < 8; ++e) { const float pp = __shfl_up(Pin[e], 8), hh = __shfl_up(Hin[e], 8); Pex[e] = ts ? pp : 1.f; Hex[e] = ts ? hh : 0.f; }
    if (ts == 7) {
#pragma unroll
        for (int e = 0; e < 8; ++e) { L[(w * 64 + co * 8 + e) * 2] = Pin[e]; L[(w * 64 + co * 8 + e) * 2 + 1] = Hin[e]; }
    }
    __syncthreads();
    float hc[8];
#pragma unroll
    for (int e = 0; e < 8; ++e) hc[e] = 0.f;
    for (int j = 0; j < w; ++j) {
#pragma unroll
        for (int e = 0; e < 8; ++e) hc[e] = L[(j * 64 + co * 8 + e) * 2] * hc[e] + L[(j * 64 + co * 8 + e) * 2 + 1];
    }
#pragma unroll
    for (int e = 0; e < 8; ++e) H[e] = Pex[e] * hc[e] + Hex[e];
#pragma unroll 2
    for (int i = 0; i < 32; ++i) {
        const size_t m = m0 + i;
        float rp[8], ip[8], xv[8], gv[8], av[8], uv[8];
        unpack8(*(const v4u*)(RI + m * 8192 + c), rp); unpack8(*(const v4u*)(RI + m * 8192 + 4096 + c), ip); unpack8(*(const v4u*)(xbc + m * D + c), xv); unpack8(*(const v4u*)(gg + m * D + c), gv);
        lru_elem(rp, ip, xv, rb, ib, sl, (t0 + i) == 0, av, uv);
        float yo[8];
#pragma unroll
        for (int e = 0; e < 8; ++e) { H[e] = av[e] * H[e] + uv[e]; yo[e] = H[e] * gv[e]; }
        *(v4u*)(Y + m * D + c) = pack8(yo);
    }
    __syncthreads();
}


#define IN(k) (lo <= (k) && (k) < hi)
#define SEAM(k) do { if (IN(k) && IN((k) + 1)) xcd_barrier(bar); } while (0)
#define SEAML(k) do { if (IN(k) && IN((k) + 1)) { if (lok) xcd_local_barrier(ctlw, bar.bar, bx & 7, (unsigned)(G >> 3)); else xcd_barrier(bar); } } while (0)

template <int Lyr>
__device__ __forceinline__ void layer_body(const Args& args, LAS unsigned char* lds, const XcdBarrier& bar) {
    const int tid = threadIdx.x, lane = tid & 63, wave = __builtin_amdgcn_readfirstlane(tid >> 6);
    const int G = gridDim.x, bx = blockIdx.x;
    const int gw = bx * NWAVES + wave, NGW = G * NWAVES;
    const size_t gt = (size_t)bx * NTHR + tid, NGT = (size_t)G * NTHR;
    unsigned char* ws = args.ws;
    const int lo = args.ph_lo, hi = args.ph_hi;
    bf16* Win = (bf16*)(ws + WS_WIN); bf16* Wout = (bf16*)(ws + (Lyr ? WS_W1P : WS_WOUT)); bf16* Wup = (bf16*)(ws + (Lyr ? WS_W1P + 32 * MiB : WS_WUP)); bf16* Wdown = (bf16*)(ws + (Lyr ? WS_W1P + 204 * MiB : WS_WDOWN));
    bf16* Wl1 = (bf16*)(ws + WS_WL1); bf16* Wg2 = (bf16*)(ws + WS_WG2); bf16* Wgates = (bf16*)(ws + WS_WGATES);
    bf16* A0 = (bf16*)(ws + WS_A0); bf16* BIG = (bf16*)(ws + WS_BIG); bf16* Yb = (bf16*)(ws + WS_Y); float* Sf = args.out; bf16* Sb = (bf16*)(ws + WS_U);
    float* SBf = (float*)(ws + WS_SB); float* Stt = (float*)(ws + WS_CTL + MiB);
    float* WApre = (float*)(ws + WS_U); bf16* Gb = (bf16*)(ws + WS_U + 256 * MiB); bf16* Ap = (bf16*)(ws + WS_U + 320 * MiB); bf16* Gp = (bf16*)(ws + WS_U + 328 * MiB);
    bf16* XBC = (bf16*)(ws + WS_BIG + 256 * MiB); bf16* GGb = (bf16*)(ws + WS_BIG); bf16* VT = (bf16*)(ws + WS_BIG + 336 * MiB); bf16* RI = (bf16*)(ws + WS_U);

        const int pb = Lyr * 11;
        const float* w_out = Lyr ? args.in[30] : args.in[13];
        const float* ln1g = Lyr ? args.in[31] : args.in[14]; const float* ln1b = Lyr ? args.in[32] : args.in[15];
        const float* ffn_up = Lyr ? args.in[33] : args.in[16]; const float* cw = Lyr ? args.in[34] : args.in[17]; const float* cb = Lyr ? args.in[35] : args.in[18];
        const float* ffn_down = Lyr ? args.in[36] : args.in[19];
        const float* ln2g = Lyr ? args.in[37] : args.in[20]; const float* ln2b = Lyr ? args.in[38] : args.in[21];
        const float* w_in = Lyr ? args.in[22] : args.in[1];
        const int n_in = Lyr ? 8192 : NIN0;

        if (IN(pb + 0)) {
            LAS float* scr = (LAS float*)(lds + RING_OFF + wave * 16384);
            const int I_IN = 64 * (n_in / 32), I_X = Lyr ? 32 * 32 : 4 * 64;
            const int NIT = I_IN + I_X;
            for (int it = gw; it < NIT; it += NGW) {
                int r = it;
                if (r < I_IN) { transpose_item(w_in, D, n_in, Win, 0, scr, r, lane); continue; } r -= I_IN;
                if (Lyr == 0) transpose_item(args.in[7], 256, 2048, Wg2, 0, scr, r, lane);
                else { const int mat = r >> 5, sub = r & 31, gsel = mat >> 4, hh = mat & 15;
                    const int n0 = 32 * (sub & 7); const int row = 256 * (2 * hh + (n0 >> 7)) + 128 * gsel + (n0 & 127);
                    transpose_item((gsel ? args.in[27] : args.in[25]) + (size_t)hh * 65536, 256, 256, Wgates, row - n0, scr, sub, lane); }
            }
            if (Lyr == 0) {
                for (size_t i = gt; i < (size_t)4096 * 256; i += NGT) { const int n = (int)(i >> 8), k = (int)(i & 255); float v = 0.f;
                    if (n < 2048) { if (k < 96) v = args.in[4][(size_t)k * 2048 + n]; } else { if (k >= 96 && k < 192) v = args.in[6][(size_t)(k - 96) * 2048 + (n - 2048)]; }
                    Wl1[i] = (bf16)f2bf(v); }
                for (size_t i = gt; i < (size_t)M * D / 8; i += NGT) { const f32x4 v0 = ((const f32x4*)args.in[0])[2 * i], v1 = ((const f32x4*)args.in[0])[2 * i + 1];
                    v4u o; o.x = pk2(v0.x, v0.y); o.y = pk2(v0.z, v0.w); o.z = pk2(v1.x, v1.y); o.w = pk2(v1.z, v1.w); ((v4u*)A0)[i] = o; }
            }
        }
        SEAM(pb + 0);
        bool lok = false;
        unsigned* const ctlw = (unsigned*)(ws + WS_CTL);
        if (!MK_PER_PHASE && G == 256) {
            volatile LAS unsigned* MISCw = (volatile LAS unsigned*)(lds + MISC_OFF);
            if (tid == 0) { unsigned okv = 1u;
                for (int c = 0; c < 8; ++c) { const unsigned mm = xb_ld(&ctlw[LB_MAP(c)]); okv &= (mm != 0u && (mm & (mm - 1u)) == 0u) ? 1u : 0u; }
                MISCw[12] = okv; }
            __syncthreads();
            lok = __builtin_amdgcn_readfirstlane((int)MISCw[12]) != 0;
            __syncthreads();
        }
        const int lnm0 = lok ? 2048 * (bx & 7) + (bx >> 3) * NWAVES + wave : gw, lnms = lok ? 256 : NGW, lnme = lok ? 2048 * (bx & 7) + 2048 : M;

        if (Lyr == 0) {
            if (IN(1)) {
                { pg8::Gemm g{A0, Win, M, NIN0P, D, D, 0, 0}; pg8::StaticOrder S; S.init(M, NIN0P, G, bx); pg8::EpiBf16 E{BIG, NIN0P};
                  pg8::gemm_phase<pg8::EpiBf16, pg8::StaticOrder, true, true>(lds + RING_OFF, g, S, E); }
                __syncthreads();
                { pg8::Gemm g{Win + (size_t)NVT0 * D, A0, 2048, M, D, D, 0, 0}; pg8::StaticOrder S; S.init(2048, M, G, bx); pg8::EpiBf16 E{VT, M};
                  pg8::gemm_phase<pg8::EpiBf16, pg8::StaticOrder, true, true>(lds + RING_OFF, g, S, E); }
            }
            SEAM(1);
            if (IN(2)) {
                for (int m = gw; m < M; m += NGW) {
                    const int t = m & (T - 1); const int sl = 8 * lane;
                    const bool isA = sl < 256; const int pc = isA ? 6144 + sl : 6336 + (sl - 256);
                    float f[8];
                    if (isA && sl >= 192) {
#pragma unroll
                        for (int e = 0; e < 8; ++e) f[e] = 0.f;
                    } else {
                        float c1[8], c0[8]; unpack8(*(const v4u*)(BIG + (size_t)m * NIN0P + pc), c1);
                        if (t > 0) unpack8(*(const v4u*)(BIG + (size_t)(m - 1) * NIN0P + pc), c0); else {
#pragma unroll
                            for (int e = 0; e < 8; ++e) c0[e] = 0.f; }
                        const f32x4 mu0 = *(const f32x4*)(args.in[2] + pc), mu1 = *(const f32x4*)(args.in[2] + pc + 4);
#pragma unroll
                        for (int e = 0; e < 8; ++e) { const float mu = e < 4 ? mu0[e] : mu1[e - 4]; const float xv = c1[e] + (c0[e] - c1[e]) * mu;
                            f[e] = isA ? (sl < 96 ? tanhf(xv) : xv) : sigmoidf_(xv); }
                    }
                    if (isA) *(v4u*)(Ap + (size_t)m * 256 + sl) = pack8(f); else *(v4u*)(Gp + (size_t)m * 256 + (sl - 256)) = pack8(f);
                }
            }
            SEAM(2);
            if (IN(3)) {
                { pg8::Gemm g{Ap, Wl1, M, 4096, 256, 256, 0, 0}; pg8::StaticOrder S; S.init(M, 4096, G, bx); pg8::EpiF32T<false> E{WApre, nullptr, 4096, 0.f, nullptr, nullptr, nullptr};
                  pg8::gemm_phase<pg8::EpiF32T<false>, pg8::StaticOrder, true, true>(lds + RING_OFF, g, S, E); }
                __syncthreads();
                { pg8::Gemm g{Gp, Wg2, M, 2048, 256, 256, 0, 0}; pg8::StaticOrder S; S.init(M, 2048, G, bx); pg8::EpiBf16 E{Gb, 2048};
                  pg8::gemm_phase<pg8::EpiBf16, pg8::StaticOrder, true, true>(lds + RING_OFF, g, S, E); }
            }
            SEAM(3);
            if (IN(4)) {
                { int nh = 0; for (int bh = bx; bh < BATCH * 32; bh += G, ++nh) rwkv_head(args, (LAS float*)(lds + RING_OFF), bh, BIG, WApre, Gb, Yb, true, nh * (T / RCH));
                  const int done_per_aw = nh * (T / RCH);
                  for (int it = done_per_aw * (G * 4) + gw; it < CV_TOTAL; it += 2 * NGW) {
                      float cva[32], cvb[32]; const CvtDesc da = cvt_desc(args, it, lane); cvt_load(cva, da);
                      const bool two = it + NGW < CV_TOTAL; const CvtDesc db = cvt_desc(args, two ? it + NGW : it, lane); if (two) cvt_load(cvb, db);
                      cvt_store(cva, da); if (two) cvt_store(cvb, db); } }
                __syncthreads();
                for (int task = gw; task < BATCH * 32 * 64; task += NGW) sba_task(task, BIG, VT, Yb, lane);
                __syncthreads();
            }
            SEAM(4);
        } else {
            if (IN(12)) { pg8::Gemm g{A0, Win, M, 8192, D, D, 0, 0}; pg8::StaticOrder S; S.init(M, 8192, G, bx); pg8::EpiLruIn E{GGb, XBC, args.in[23], args.in[24], SBf};
                pg8::gemm_phase<pg8::EpiLruIn, pg8::StaticOrder, true, true>(lds + RING_OFF, g, S, E); }
            SEAM(12);
            if (IN(13)) {
                for (size_t i = gt; i < (size_t)128 * 3 * 512; i += NGT) {
                    const int c = (int)(i & 511) * 8, gi = (int)(i >> 9), grp = gi / 3, ti = gi - 3 * grp;
                    const bool seq0 = (grp & 15) == 0;
                    float ov[8];
#pragma unroll
                    for (int q = 0; q < 2; ++q) {
                        const int cc = c + 4 * q;
                        const float* sb = SBf + (size_t)grp * 6 * 4096 + cc;
                        f32x4 xs[6];
#pragma unroll
                        for (int k = 0; k < 3; ++k) { xs[k] = seq0 ? (f32x4){0.f, 0.f, 0.f, 0.f} : *(const f32x4*)(sb - (size_t)(3 - k) * 4096); xs[3 + k] = *(const f32x4*)(sb + (size_t)k * 4096); }
                        f32x4 r = *(const f32x4*)(args.in[24] + cc);
#pragma unroll
                        for (int k = 0; k < 4; ++k) { const f32x4 wk = *(const f32x4*)(args.in[23] + (size_t)k * 4096 + cc);
                            const f32x4 xv = ti == 0 ? xs[k] : (ti == 1 ? xs[k + 1] : xs[k + 2]); r += wk * xv; }
#pragma unroll
                        for (int e = 0; e < 4; ++e) ov[4 * q + e] = r[e];
                    }
                    *(v4u*)(XBC + (size_t)(grp * 128 + ti) * D + c) = pack8(ov);
                }
            }
            SEAM(13);
            if (IN(14)) { pg8::Gemm g{XBC, Wgates, M, 8192, 256, D, 16, 256, 1}; pg8::ChainOrder S{G, bx};
                pg8::EpiLruScan E{XBC, GGb, Yb, args.in[26], args.in[28], args.in[29], (LAS float*)(lds + RING_BYTES + 1024)};
                pg8::gemm_phase<pg8::EpiLruScan, pg8::ChainOrder, true, true>(lds + RING_OFF, g, S, E); }
            SEAM(14);
        }

        if (IN(pb + 5)) { pg8::Gemm g{Yb, Wout, M, D, D, D, 0, 0}; pg8::StaticOrder S; S.init(M, D, G, bx);
            pg8::EpiRes<Lyr == 1, false, Lyr == 0> E{Sb, Lyr ? (const void*)Sb : (const void*)A0, Stt, args.in[20], args.in[21]};
            pg8::gemm_phase<pg8::EpiRes<Lyr == 1, false, Lyr == 0>, pg8::StaticOrder, true, true>(lds + RING_OFF, g, S, E); }
        SEAML(pb + 5);
        if (IN(pb + 6)) ln_rows_b(Sb, ln1g, ln1b, A0, Stt, lnm0, lnms, lnme, lane);
        SEAML(pb + 6);
        if (IN(pb + 7)) { pg8::Gemm g{A0, Wup, M, FF2, D, D, 0, 0}; pg8::StaticOrder S; S.init(M, FF2, G, bx); pg8::EpiFfnUp E{BIG, cw, cb, SBf, FF};
            pg8::gemm_phase<pg8::EpiFfnUp, pg8::StaticOrder, true, true>(lds + RING_OFF, g, S, E); }
        SEAML(pb + 7);
        if (IN(pb + 8)) {
            const size_t fx0 = lok ? (size_t)(bx >> 3) * NTHR + tid : gt, fxs = lok ? (size_t)(G >> 3) * NTHR : NGT, fxn = (size_t)(lok ? 16 : 128) * 2 * (FF / 8); const int fxg = lok ? 16 * (bx & 7) : 0;
            for (size_t i = fx0; i < fxn; i += fxs) {
                const int c = (int)(i % (FF / 8)) * 8, gi = (int)(i / (FF / 8)), grp = fxg + (gi >> 1), ti = gi & 1;
                const bool seq0 = (grp & 15) == 0;
                float hv[8];
#pragma unroll
                for (int q = 0; q < 2; ++q) {
                    const int cc = c + 4 * q;
                    f32x4 cg, cv;
#pragma unroll
                    for (int gv = 0; gv < 2; ++gv) {
                        const int off = gv * FF + cc;
                        const float* sb = SBf + (size_t)grp * 4 * FF2 + off;
                        const f32x4 u0 = *(const f32x4*)(sb), u1 = *(const f32x4*)(sb + FF2);
                        f32x4 um1 = (f32x4){0.f, 0.f, 0.f, 0.f}, um2 = um1;
                        if (!seq0) { um2 = *(const f32x4*)(sb - 2 * FF2); um1 = *(const f32x4*)(sb - FF2); }
                        const f32x4 w0 = *(const f32x4*)(cw + off), w1 = *(const f32x4*)(cw + FF2 + off), w2 = *(const f32x4*)(cw + 2 * FF2 + off), bb = *(const f32x4*)(cb + off);
                        const f32x4 r = ti == 0 ? bb + w2 * u0 + w1 * um1 + w0 * um2 : bb + w2 * u1 + w1 * u0 + w0 * um1;
                        if (gv == 0) cg = r; else cv = r;
                    }
#pragma unroll
                    for (int e = 0; e < 4; ++e) hv[4 * q + e] = cg[e] * sigmoidf_(cg[e]) * cv[e];
                }
                *(v4u*)(BIG + (size_t)(grp * 128 + ti) * FF + c) = pack8(hv);
            }
        }
        SEAML(pb + 8);
        if (IN(pb + 9)) { pg8::Gemm g{BIG, Wdown, M, D, FF, FF, 0, 0}; pg8::StaticOrder S; S.init(M, D, G, bx); pg8::EpiRes<true, false> E{(void*)Sb, Sb, Stt, ln1g, ln1b};
            pg8::gemm_phase<pg8::EpiRes<true, false>, pg8::StaticOrder, true, true>(lds + RING_OFF, g, S, E); }
        SEAML(pb + 9);
        if (IN(pb + 10)) { if (Lyr) ln_rows_bf(Sb, ln2g, ln2b, args.out, lnm0, lnms, lnme, lane); else ln_rows_b(Sb, ln2g, ln2b, A0, Stt, lnm0, lnms, lnme, lane); }
        SEAM(pb + 10);
    }
__global__ void __launch_bounds__(NTHR, 2) trunk_fwd(Args args) {
    extern __shared__ __attribute__((aligned(16))) unsigned char lds_raw[];
    LAS unsigned char* lds = (LAS unsigned char*)lds_raw;
    volatile LAS unsigned* MISC = (volatile LAS unsigned*)(lds + MISC_OFF);
    const int tid = threadIdx.x, lane = tid & 63, wave = __builtin_amdgcn_readfirstlane(tid >> 6);
    const int G = gridDim.x, bx = blockIdx.x;
    const int gw = bx * NWAVES + wave, NGW = G * NWAVES;
    const size_t gt = (size_t)bx * NTHR + tid, NGT = (size_t)G * NTHR;
    unsigned char* ws = args.ws;
    unsigned* ctl = (unsigned*)(ws + WS_CTL);
    for (int u = tid; u < (LDS_BYTES - LDSCTL_OFF) / 4; u += NTHR) ((LAS unsigned*)(lds + LDSCTL_OFF))[u] = 0u;
    __syncthreads();
    XcdBarrier bar; bar.bar = ctl + CW_BAR; bar.x = 0; bar.st = nullptr;
    if (!MK_PER_PHASE) { bar = xcd_barrier_post(ctl + CW_BAR, MISC + 8); if (tid == 0) (void)__hip_atomic_fetch_or(&ctl[LB_MAP(bx & 7)], 1u << bar.x, __ATOMIC_RELAXED, __HIP_MEMORY_SCOPE_AGENT); }

    layer_body<0>(args, lds, bar);
    layer_body<1>(args, lds, bar);
}


extern "C" void kernel_launch(void* const* d_in, const int* in_sizes, int n_in, void* d_out, int out_size, void* d_ws, size_t ws_size, hipStream_t stream) {
    static int grid = 0;
    if (grid == 0) {
        if (n_in != 39 || in_sizes[0] != M * D || out_size != M * D || ws_size < WS_END) {
            fprintf(stderr, "kernel_launch: unexpected shapes: n_in %d in0 %d out %d ws %zu (need %zu); nothing launched\n", n_in, n_in > 0 ? in_sizes[0] : -1, out_size, ws_size, (size_t)WS_END); grid = -1; return; }
        int dev = 0, cus = 0, per_cu = 0;
        if (hipGetDevice(&dev) != hipSuccess || hipDeviceGetAttribute(&cus, hipDeviceAttributeMultiprocessorCount, dev) != hipSuccess) { grid = -1; return; }
        if (hipFuncSetAttribute((const void*)trunk_fwd, hipFuncAttributeMaxDynamicSharedMemorySize, LDS_BYTES) != hipSuccess) { fprintf(stderr, "kernel_launch: hipFuncSetAttribute failed\n"); grid = -1; return; }
        if (hipOccupancyMaxActiveBlocksPerMultiprocessor(&per_cu, (const void*)trunk_fwd, NTHR, LDS_BYTES) != hipSuccess || per_cu < 1)
            fprintf(stderr, "kernel_launch: note: occupancy query reports %d workgroups per CU\n", per_cu);
        (void)hipGetLastError();
        grid = cus;
    }
    if (grid < 0) return;
    if (hipMemsetAsync((char*)d_ws + WS_CTL, 0, CTL_ZERO_BYTES, stream) != hipSuccess) return;
    Args a{};
    for (int i = 0; i < 39; ++i) a.in[i] = (const float*)d_in[i];
    a.out = (float*)d_out; a.ws = (unsigned char*)d_ws;
#if MK_PER_PHASE
    for (int ph = 0; ph < NPHASE; ++ph) { const int reps = ((PROBE_MASK >> ph) & 1u) ? 2 : 1; for (int r = 0; r < reps; ++r) { a.ph_lo = ph; a.ph_hi = ph + 1; hipLaunchKernelGGL(trunk_fwd, dim3(grid), dim3(NTHR), LDS_BYTES, stream, a); } }
#else
    a.ph_lo = 0; a.ph_hi = NPHASE;
    hipLaunchKernelGGL(trunk_fwd, dim3(grid), dim3(NTHR), LDS_BYTES, stream, a);
#endif
    const hipError_t le = hipPeekAtLastError();
    if (le != hipSuccess) fprintf(stderr, "kernel_launch: launch failed: %s\n", hipGetErrorName(le));
}
```

```cpp
#include <hip/hip_runtime.h>
#include <cstdio>
#include <cstdint>

namespace pg8 {
#define PG8_LAS __attribute__((address_space(3)))
typedef unsigned short bf16_t;
typedef short bf16x8 __attribute__((ext_vector_type(8)));
typedef float f32x4 __attribute__((ext_vector_type(4)));
typedef unsigned u32x4 __attribute__((ext_vector_type(4)));
constexpr int BM = 256, BK = 64, HALF = 128, HTB = HALF * BK * 2  , STAGE_BYTES = 8 * HTB, NXCD = 8, WGM = 8;

__host__ __device__ __forceinline__ int lds_byte(int r, int c) { const int st = (r >> 4) * 2 + (c >> 5), rr = r & 15, cc = c & 31, ob = rr * 64 + cc * 2; return st * 1024 + (ob ^ (((ob >> 9) & 1) << 5)); }
__host__ __device__ __forceinline__ void stage_rc(int b, int& R, int& C) { const int st = b / 1024, sb = b % 1024, swz = sb ^ (((sb >> 9) & 1) << 5); R = (st >> 1) * 16 + swz / 64; C = (st & 1) * 32 + (swz % 64) / 2; }
__host__ __device__ __forceinline__ int perm32(int rho) { const int n = rho >> 4, i = rho & 15; return 8 * (i >> 2) + 4 * n + (i & 3); }

struct Unit { int pm, pn; };
struct Gemm { const bf16_t* A; const bf16_t* Bt; int M, N, K, lda, a_mod, a_stride, a_shift; };

struct StaticOrder {
    int nM, nN, nwg, G, c;
    __host__ __device__ void init(int M, int N, int G_, int c_) { nM = M / BM; nN = N / BM; nwg = nM * nN; G = G_; c = c_; }
    __host__ __device__ bool next(int i, Unit& u) const {
        const long L = (long)i * G + c; if (L >= nwg) return false;
        int wgid = (int)L; { const int q = nwg / NXCD, r = nwg % NXCD, xcd = wgid % NXCD, off = wgid / NXCD; wgid = (xcd < r ? xcd * (q + 1) : r * (q + 1) + (xcd - r) * q) + off; }
        const int nig = WGM * nN, gid = wgid / nig, fm = gid * WGM, gsz = (nM - fm) < WGM ? (nM - fm) : WGM;
        u.pm = fm + ((wgid % nig) % gsz); u.pn = (wgid % nig) / gsz; return true;
    }
    __device__ __forceinline__ void a_ready(const Unit&) const {}
    __device__ __forceinline__ void done(const Unit&) const {}
};

__device__ __forceinline__ unsigned cvt_pk_bf16(float lo, float hi) { unsigned r; asm volatile("v_cvt_pk_bf16_f32 %0, %1, %2" : "=v"(r) : "v"(lo), "v"(hi)); return r; }

struct EpiBf16 {
    static constexpr bool PERM = true, AFTER_DRAIN = false, TOKPERM = false;
    bf16_t* O; int ldc;
    __device__ __forceinline__ void operator()(const f32x4 (&acc)[2][2][4][2], const Unit& u, int wr, int wc, int fr, int fq) const {
        const int row0 = u.pm * BM + wr * 64 + fr; const int col0 = u.pn * BM + wc * 32 + 8 * fq;
#pragma unroll
        for (int ai = 0; ai < 2; ++ai)
#pragma unroll
            for (int m = 0; m < 4; ++m) { bf16_t* rowp = O + (size_t)(row0 + ai * HALF + m * 16) * ldc + col0;
#pragma unroll
                for (int bj = 0; bj < 2; ++bj) { const f32x4 v0 = acc[ai][bj][m][0], v1 = acc[ai][bj][m][1];
                    u32x4 w; w.x = cvt_pk_bf16(v0[0], v0[1]); w.y = cvt_pk_bf16(v0[2], v0[3]); w.z = cvt_pk_bf16(v1[0], v1[1]); w.w = cvt_pk_bf16(v1[2], v1[3]);
                    *(u32x4*)(rowp + bj * HALF) = w; } }
    }
};
template <bool LNB> struct EpiF32T {
    static constexpr bool PERM = false, AFTER_DRAIN = false, TOKPERM = false;
    float* C; const float* base; int ldc; float alpha; const float* stats; const float* lg; const float* lb;
    __device__ __forceinline__ void operator()(const f32x4 (&acc)[2][2][4][2], const Unit& u, int wr, int wc, int fr, int fq) const {
        float* const C = this->C; const float* const base = this->base; const float* const stats = this->stats; const int ldc = this->ldc; const float alpha = this->alpha;
        const int row0 = u.pm * BM + wr * 64 + fr, col0 = u.pn * BM + wc * 32 + 4 * fq;
        f32x4 gv[2][2], bv[2][2];
        if constexpr (LNB) {
#pragma unroll
            for (int bj = 0; bj < 2; ++bj)
#pragma unroll
                for (int n = 0; n < 2; ++n) { gv[bj][n] = *(const f32x4*)(lg + col0 + bj * HALF + n * 16) * alpha; bv[bj][n] = *(const f32x4*)(lb + col0 + bj * HALF + n * 16) * alpha; }
        }
#pragma unroll
        for (int ai = 0; ai < 2; ++ai)
#pragma unroll
            for (int m = 0; m < 4; ++m) { const int row = row0 + ai * HALF + m * 16; const size_t off = (size_t)row * ldc + col0;
                f32x4 bs[2][2];
#pragma unroll
                for (int bj = 0; bj < 2; ++bj)
#pragma unroll
                    for (int n = 0; n < 2; ++n) bs[bj][n] = base ? *(const f32x4*)(base + off + bj * HALF + n * 16) : (f32x4){0.f, 0.f, 0.f, 0.f};
                if constexpr (LNB) { const float mean = stats[2 * row], rstd = stats[2 * row + 1];
#pragma unroll
                    for (int bj = 0; bj < 2; ++bj)
#pragma unroll
                        for (int n = 0; n < 2; ++n) *(f32x4*)(C + off + bj * HALF + n * 16) = acc[ai][bj][m][n] + ((bs[bj][n] - mean) * rstd * gv[bj][n] + bv[bj][n]);
                } else {
#pragma unroll
                    for (int bj = 0; bj < 2; ++bj)
#pragma unroll
                        for (int n = 0; n < 2; ++n) *(f32x4*)(C + off + bj * HALF + n * 16) = acc[ai][bj][m][n] + bs[bj][n] * alpha;
                }
                asm volatile("" ::: "memory"); }
    }
};

template <bool LNB, bool OUTF32, bool XBF = false> struct EpiRes {
    static constexpr bool PERM = true, AFTER_DRAIN = false, TOKPERM = false;
    void* Cout; const void* base; const float* stats; const float* lg; const float* lb;
    __device__ __forceinline__ void operator()(const f32x4 (&acc)[2][2][4][2], const Unit& u, int wr, int wc, int fr, int fq) const {
        void* const Cout = this->Cout; const void* const base = this->base; const float* const stats = this->stats; const float* const lg = this->lg; const float* const lb = this->lb;
        constexpr float alpha = 1.41421356237309515f; constexpr int ldc = 4096;
        const int row0 = u.pm * BM + wr * 64 + fr, col0 = u.pn * BM + wc * 32 + 8 * fq;
        f32x4 g0[2], g1[2], b0[2], b1[2];
        if constexpr (LNB) {
#pragma unroll
            for (int bj = 0; bj < 2; ++bj) { g0[bj] = *(const f32x4*)(lg + col0 + bj * HALF) * alpha; g1[bj] = *(const f32x4*)(lg + col0 + bj * HALF + 4) * alpha;
                b0[bj] = *(const f32x4*)(lb + col0 + bj * HALF) * alpha; b1[bj] = *(const f32x4*)(lb + col0 + bj * HALF + 4) * alpha; }
        }
#pragma unroll
        for (int ai = 0; ai < 2; ++ai)
#pragma unroll
            for (int m = 0; m < 4; ++m) { const int row = row0 + ai * HALF + m * 16; const size_t off = (size_t)row * ldc + col0;
                f32x4 x0[2], x1[2];
#pragma unroll
                for (int bj = 0; bj < 2; ++bj) {
                    if constexpr (LNB) { const u32x4 w = *(const u32x4*)((const bf16_t*)base + off + bj * HALF);
                        x0[bj] = (f32x4){__uint_as_float(w.x << 16), __uint_as_float(w.x & 0xffff0000u), __uint_as_float(w.y << 16), __uint_as_float(w.y & 0xffff0000u)};
                        x1[bj] = (f32x4){__uint_as_float(w.z << 16), __uint_as_float(w.z & 0xffff0000u), __uint_as_float(w.w << 16), __uint_as_float(w.w & 0xffff0000u)}; }
                    else if constexpr (XBF) { const u32x4 w = *(const u32x4*)((const bf16_t*)base + off + bj * HALF);
                        x0[bj] = (f32x4){__uint_as_float(w.x << 16), __uint_as_float(w.x & 0xffff0000u), __uint_as_float(w.y << 16), __uint_as_float(w.y & 0xffff0000u)};
                        x1[bj] = (f32x4){__uint_as_float(w.z << 16), __uint_as_float(w.z & 0xffff0000u), __uint_as_float(w.w << 16), __uint_as_float(w.w & 0xffff0000u)}; }
                    else { x0[bj] = *(const f32x4*)((const float*)base + off + bj * HALF); x1[bj] = *(const f32x4*)((const float*)base + off + bj * HALF + 4); }
                }
                float mean = 0.f, rstd = 0.f; if constexpr (LNB) { mean = stats[2 * row]; rstd = stats[2 * row + 1]; }
#pragma unroll
                for (int bj = 0; bj < 2; ++bj) { f32x4 o0, o1;
                    if constexpr (LNB) { o0 = acc[ai][bj][m][0] + ((x0[bj] - mean) * rstd * g0[bj] + b0[bj]); o1 = acc[ai][bj][m][1] + ((x1[bj] - mean) * rstd * g1[bj] + b1[bj]); }
                    else { o0 = acc[ai][bj][m][0] + x0[bj] * alpha; o1 = acc[ai][bj][m][1] + x1[bj] * alpha; }
                    if constexpr (OUTF32) { *(f32x4*)((float*)Cout + off + bj * HALF) = o0; *(f32x4*)((float*)Cout + off + bj * HALF + 4) = o1; }
                    else { u32x4 w; w.x = cvt_pk_bf16(o0[0], o0[1]); w.y = cvt_pk_bf16(o0[2], o0[3]); w.z = cvt_pk_bf16(o1[0], o1[1]); w.w = cvt_pk_bf16(o1[2], o1[3]); *(u32x4*)((bf16_t*)Cout + off + bj * HALF) = w; }
                }
                if (m & 1) __builtin_amdgcn_sched_barrier(0); }
    }
};

template <int CTRL> __device__ __forceinline__ float dppf(float v) { return __builtin_bit_cast(float, __builtin_amdgcn_update_dpp(0, __builtin_bit_cast(int, v), CTRL, 0xF, 0xF, true)); }
struct EpiFfnUp {
    static constexpr bool PERM = true, AFTER_DRAIN = false, TOKPERM = true;
    bf16_t* Hout; const float* cw; const float* cb; float* SB; int ff;
    __device__ __forceinline__ void operator()(const f32x4 (&acc)[2][2][4][2], const Unit& u, int wr, int wc, int fr, int fq) const {
        const int tb = u.pm * BM + wr * 128 + fr * 8;
        const int hc0 = u.pn * 128 + wc * 32 + fq * 8;
        const int grp = 2 * u.pm + wr; const int ff2 = 2 * ff;
        unsigned hres[8][4];
#pragma unroll
        for (int n = 0; n < 2; ++n) {
            const int hc = hc0 + 4 * n;
            const f32x4 wg0 = *(const f32x4*)(cw + hc), wg1 = *(const f32x4*)(cw + ff2 + hc), wg2 = *(const f32x4*)(cw + 2 * ff2 + hc), bg = *(const f32x4*)(cb + hc);
            const f32x4 wv0 = *(const f32x4*)(cw + ff + hc), wv1 = *(const f32x4*)(cw + ff2 + ff + hc), wv2 = *(const f32x4*)(cw + 2 * ff2 + ff + hc), bv = *(const f32x4*)(cb + ff + hc);
            {
                const bool lo = fr == 0;
                const f32x4 e0 = lo ? acc[0][0][0][n] : acc[1][0][2][n], e1 = lo ? acc[0][1][0][n] : acc[1][1][2][n], e2 = lo ? acc[0][0][1][n] : acc[1][0][3][n], e3 = lo ? acc[0][1][1][n] : acc[1][1][3][n];
                if (fr == 0 || fr == 15) { float* sb = SB + ((size_t)grp * 4 + (lo ? 0 : 2)) * ff2 + hc; *(f32x4*)(sb) = e0; *(f32x4*)(sb + ff) = e1; *(f32x4*)(sb + ff2) = e2; *(f32x4*)(sb + ff2 + ff) = e3; }
            }
            float hv[8][4];
#pragma unroll
            for (int j = 0; j < 4; ++j) {
                float gq[8], vq[8];
#pragma unroll
                for (int i = 0; i < 8; ++i) { gq[i] = acc[i >> 2][0][i & 3][n][j]; vq[i] = acc[i >> 2][1][i & 3][n][j]; }
                const float pg1 = dppf<0x111>(gq[7]), pg2 = dppf<0x111>(gq[6]), pv1 = dppf<0x111>(vq[7]), pv2 = dppf<0x111>(vq[6]);
#pragma unroll
                for (int i = 0; i < 8; ++i) {
                    const float g1 = i >= 1 ? gq[i >= 1 ? i - 1 : 0] : pg1, g2 = i >= 2 ? gq[i >= 2 ? i - 2 : 0] : (i == 1 ? pg1 : pg2);
                    const float v1 = i >= 1 ? vq[i >= 1 ? i - 1 : 0] : pv1, v2 = i >= 2 ? vq[i >= 2 ? i - 2 : 0] : (i == 1 ? pv1 : pv2);
                    const float cg = bg[j] + wg2[j] * gq[i] + wg1[j] * g1 + wg0[j] * g2;
                    const float cv = bv[j] + wv2[j] * vq[i] + wv1[j] * v1 + wv0[j] * v2;
                    hv[i][j] = cg * cv * __builtin_amdgcn_rcpf(1.0f + __expf(-cg));
                }
            }
#pragma unroll
            for (int i = 0; i < 8; ++i) { hres[i][2 * n] = cvt_pk_bf16(hv[i][0], hv[i][1]); hres[i][2 * n + 1] = cvt_pk_bf16(hv[i][2], hv[i][3]); }
        }
#pragma unroll
        for (int i = 0; i < 8; ++i) { u32x4 w; w.x = hres[i][0]; w.y = hres[i][1]; w.z = hres[i][2]; w.w = hres[i][3]; *(u32x4*)(Hout + (size_t)(tb + i) * ff + hc0) = w; }
    }
};

struct EpiLruIn {
    static constexpr bool PERM = true, AFTER_DRAIN = false, TOKPERM = true;
    bf16_t* GG; bf16_t* XBC; const float* cw; const float* cb; float* SB;
    __device__ __forceinline__ void operator()(const f32x4 (&acc)[2][2][4][2], const Unit& u, int wr, int wc, int fr, int fq) const {
        const int tb = u.pm * BM + wr * 128 + fr * 8;
        if (u.pn < 16) {
            const int col0 = u.pn * BM + wc * 32 + fq * 8;
#pragma unroll
            for (int i = 0; i < 8; ++i)
#pragma unroll
                for (int bj = 0; bj < 2; ++bj) { float f[8];
#pragma unroll
                    for (int e = 0; e < 8; ++e) { const float x = acc[i >> 2][bj][i & 3][e >> 2][e & 3];
                        const float z = 1.5957691216057308f * (x + 0.044715f * x * x * x); f[e] = x * __builtin_amdgcn_rcpf(1.0f + __expf(-z)); }
                    u32x4 w; w.x = cvt_pk_bf16(f[0], f[1]); w.y = cvt_pk_bf16(f[2], f[3]); w.z = cvt_pk_bf16(f[4], f[5]); w.w = cvt_pk_bf16(f[6], f[7]);
                    *(u32x4*)(GG + (size_t)(tb + i) * 4096 + col0 + bj * HALF) = w; }
        } else {
            const int c0 = (u.pn - 16) * BM + wc * 32 + fq * 8; const int grp = 2 * u.pm + wr;
#pragma unroll
            for (int bj = 0; bj < 2; ++bj) {
                unsigned hres[8][4];
#pragma unroll
                for (int n = 0; n < 2; ++n) {
                    const int c = c0 + bj * HALF + 4 * n;
                    const f32x4 w0 = *(const f32x4*)(cw + c), w1 = *(const f32x4*)(cw + 4096 + c), w2 = *(const f32x4*)(cw + 2 * 4096 + c), w3 = *(const f32x4*)(cw + 3 * 4096 + c), bb = *(const f32x4*)(cb + c);
                    {   const bool lo = fr == 0;
                        const f32x4 e0 = lo ? acc[0][bj][0][n] : acc[1][bj][1][n], e1 = lo ? acc[0][bj][1][n] : acc[1][bj][2][n], e2 = lo ? acc[0][bj][2][n] : acc[1][bj][3][n];
                        if (fr == 0 || fr == 15) { float* sb = SB + ((size_t)grp * 6 + (lo ? 0 : 3)) * 4096 + c; *(f32x4*)(sb) = e0; *(f32x4*)(sb + 4096) = e1; *(f32x4*)(sb + 2 * 4096) = e2; } }
                    float hv[8][4];
#pragma unroll
                    for (int j = 0; j < 4; ++j) {
                        float xq[8];
#pragma unroll
                        for (int i = 0; i < 8; ++i) xq[i] = acc[i >> 2][bj][i & 3][n][j];
                        const float p1 = dppf<0x111>(xq[7]), p2 = dppf<0x111>(xq[6]), p3 = dppf<0x111>(xq[5]);
#pragma unroll
                        for (int i = 0; i < 8; ++i) {
                            const float x1 = i >= 1 ? xq[i >= 1 ? i - 1 : 0] : p1;
                            const float x2 = i >= 2 ? xq[i >= 2 ? i - 2 : 0] : (i == 1 ? p1 : p2);
                            const float x3 = i >= 3 ? xq[i >= 3 ? i - 3 : 0] : (i == 2 ? p1 : (i == 1 ? p2 : p3));
                            hv[i][j] = bb[j] + w3[j] * xq[i] + w2[j] * x1 + w1[j] * x2 + w0[j] * x3;
                        }
                    }
#pragma unroll
                    for (int i = 0; i < 8; ++i) { hres[i][2 * n] = cvt_pk_bf16(hv[i][0], hv[i][1]); hres[i][2 * n + 1] = cvt_pk_bf16(hv[i][2], hv[i][3]); }
                }
#pragma unroll
                for (int i = 0; i < 8; ++i) { u32x4 w; w.x = hres[i][0]; w.y = hres[i][1]; w.z = hres[i][2]; w.w = hres[i][3]; *(u32x4*)(XBC + (size_t)(tb + i) * 4096 + c0 + bj * HALF) = w; }
            }
        }
    }
};

struct ChainOrder {
    int G, c;
    __device__ __forceinline__ bool next(int i, Unit& u) const { const int chain = c + (i >> 3) * G; if (chain >= 256) return false; u.pm = 8 * (chain >> 5) + (i & 7); u.pn = chain & 31; return true; }
    __device__ __forceinline__ void a_ready(const Unit&) const {}
    __device__ __forceinline__ void done(const Unit&) const {}
};
template <int CTRL> __device__ __forceinline__ float dpp_keep(float oldv, float v) { return __builtin_bit_cast(float, __builtin_amdgcn_update_dpp(__builtin_bit_cast(int, oldv), __builtin_bit_cast(int, v), CTRL, 0xF, 0xF, false)); }
struct EpiLruScan {
    static constexpr bool PERM = true, AFTER_DRAIN = false, TOKPERM = true;
    const bf16_t* XBC; const bf16_t* GG; bf16_t* Y; const float* rbias; const float* ibias; const float* lam; PG8_LAS float* X;
    __device__ __forceinline__ void operator()(const f32x4 (&acc)[2][2][4][2], const Unit& u, int wr, int wc, int fr, int fq) const {
        const int tb = u.pm * BM + wr * 128 + fr * 8;
        const int chl = wc * 32 + fq * 8, ch = (u.pn >> 1) * 256 + (u.pn & 1) * 128 + chl;
        const int jt = u.pm & 7; const bool t0lane = (jt == 0) && (wr == 0) && (fr == 0);
        float Av[8][8], Uv[8][8];
#pragma unroll
        for (int n = 0; n < 2; ++n) {
            const f32x4 rb = *(const f32x4*)(rbias + ch + 4 * n), ib = *(const f32x4*)(ibias + ch + 4 * n), lm = *(const f32x4*)(lam + ch + 4 * n);
            f32x4 sl;
#pragma unroll
            for (int j = 0; j < 4; ++j) { const float nl = -lm[j]; sl[j] = 8.0f * (fmaxf(nl, 0.f) + __logf(1.0f + __expf(-fabsf(nl)))); }
#pragma unroll
            for (int i = 0; i < 8; ++i) {
                const unsigned long long xw = *(const unsigned long long*)(XBC + (size_t)(tb + i) * 4096 + ch + 4 * n);
                const unsigned xl = (unsigned)xw, xh = (unsigned)(xw >> 32);
                const f32x4 xv = (f32x4){__uint_as_float(xl << 16), __uint_as_float(xl & 0xffff0000u), __uint_as_float(xh << 16), __uint_as_float(xh & 0xffff0000u)};
#pragma unroll
                for (int j = 0; j < 4; ++j) {
                    const int c = 4 * n + j;
                    const float rp = acc[i >> 2][0][i & 3][n][j] + rb[j], ip = acc[i >> 2][1][i & 3][n][j] + ib[j];
                    const float rg = __builtin_amdgcn_rcpf(1.0f + __expf(-rp)), ig = __builtin_amdgcn_rcpf(1.0f + __expf(-ip));
                    const float la = -rg * sl[j], a = __expf(la), x2 = la + la;
                    const float poly = -x2 * (1.0f + x2 * (0.5f + x2 * (0.16666667f + x2 * (0.041666668f + x2 * 0.0083333338f))));
                    const float em = x2 > -0.3f ? poly : 1.0f - a * a;
                    float mult = __builtin_amdgcn_sqrtf(em); if (t0lane && i == 0) mult = 1.0f;
                    Av[i][c] = a; Uv[i][c] = mult * ig * xv[j];
                }
                __builtin_amdgcn_sched_barrier(0);
            }
        }
        __builtin_amdgcn_sched_barrier(0);
        float Pex[8], Hex[8];
#pragma unroll
        for (int c = 0; c < 8; ++c) {
#pragma unroll
            for (int i = 1; i < 8; ++i) { Uv[i][c] = Av[i][c] * Uv[i - 1][c] + Uv[i][c]; Av[i][c] = Av[i][c] * Av[i - 1][c]; }
            float P = Av[7][c], H = Uv[7][c];
            { const float pp = dpp_keep<0x111>(1.0f, P), hh = dpp_keep<0x111>(0.0f, H); H = P * hh + H; P = P * pp; }
            { const float pp = dpp_keep<0x112>(1.0f, P), hh = dpp_keep<0x112>(0.0f, H); H = P * hh + H; P = P * pp; }
            { const float pp = dpp_keep<0x114>(1.0f, P), hh = dpp_keep<0x114>(0.0f, H); H = P * hh + H; P = P * pp; }
            { const float pp = dpp_keep<0x118>(1.0f, P), hh = dpp_keep<0x118>(0.0f, H); H = P * hh + H; P = P * pp; }
            Pex[c] = dpp_keep<0x111>(1.0f, P); Hex[c] = dpp_keep<0x111>(0.0f, H);
            if (wr == 0 && fr == 15) { X[(chl + c) * 2] = P; X[(chl + c) * 2 + 1] = H; }
            __builtin_amdgcn_sched_barrier(0);
        }
        asm volatile("s_waitcnt lgkmcnt(0)" ::: "memory"); __builtin_amdgcn_s_barrier(); asm volatile("" ::: "memory");
        PG8_LAS float* CARr = X + 256 + ((jt & 1) ^ 1) * 256; PG8_LAS float* CARw = X + 256 + (jt & 1) * 256;
#pragma unroll
        for (int c = 0; c < 8; ++c) {
            const float car = jt == 0 ? 0.0f : CARr[(chl + c) * 2];
            const float w0P = X[(chl + c) * 2], w0H = X[(chl + c) * 2 + 1];
            const float cwv = wr ? (w0P * car + w0H) : car;
            const float lc = Pex[c] * cwv + Hex[c];
#pragma unroll
            for (int i = 0; i < 8; ++i) Uv[i][c] = Uv[i][c] + Av[i][c] * lc;
            if (wr == 1 && fr == 15) CARw[(chl + c) * 2] = Uv[7][c];
            __builtin_amdgcn_sched_barrier(0);
        }
#pragma unroll
        for (int i = 0; i < 8; ++i) {
            const u32x4 gw = *(const u32x4*)(GG + (size_t)(tb + i) * 4096 + ch);
            float gv[8]; gv[0] = __uint_as_float(gw.x << 16); gv[1] = __uint_as_float(gw.x & 0xffff0000u); gv[2] = __uint_as_float(gw.y << 16); gv[3] = __uint_as_float(gw.y & 0xffff0000u);
            gv[4] = __uint_as_float(gw.z << 16); gv[5] = __uint_as_float(gw.z & 0xffff0000u); gv[6] = __uint_as_float(gw.w << 16); gv[7] = __uint_as_float(gw.w & 0xffff0000u);
            u32x4 w; w.x = cvt_pk_bf16(Uv[i][0] * gv[0], Uv[i][1] * gv[1]); w.y = cvt_pk_bf16(Uv[i][2] * gv[2], Uv[i][3] * gv[3]); w.z = cvt_pk_bf16(Uv[i][4] * gv[4], Uv[i][5] * gv[5]); w.w = cvt_pk_bf16(Uv[i][6] * gv[6], Uv[i][7] * gv[7]);
            *(u32x4*)(Y + (size_t)(tb + i) * 4096 + ch) = w;
            if (i & 1) __builtin_amdgcn_sched_barrier(0);
        }
    }
};

template <class Epi, class Sched, bool ALIGN_EPI = false, bool SP2 = false>
__device__ __forceinline__ void gemm_phase(PG8_LAS unsigned char* lds, const Gemm g, const Sched& S, const Epi& E) {
    const int tid = threadIdx.x, wid = __builtin_amdgcn_readfirstlane(tid >> 6), lane = tid & 63, wr = wid >> 2, wc = wid & 3, fr = lane & 15, fq = lane >> 4;
    const int K = g.K, nt = K / BK;
    unsigned voffA[2], voffB[2];
#pragma unroll
    for (int i = 0; i < 2; ++i) { int R, C; stage_rc(tid * 16 + i * 8192, R, C); const int Rb = Epi::PERM ? ((R & ~31) + perm32(R & 31)) : R;
        const int Ra = Epi::TOKPERM ? (128 * (R >> 6) + 8 * (R & 15) + ((R >> 4) & 3)) : R;
        voffA[i] = (unsigned)(Ra * g.lda + C) * 2u; voffB[i] = (unsigned)(Rb * K + C) * 2u; }
    const size_t kstep = (size_t)(BK * 2);
    const size_t hstepA = (size_t)(Epi::TOKPERM ? 4 : HALF) * g.lda * 2, hstepB = (size_t)HALF * K * 2;
    const size_t tstepA = (size_t)BM * g.lda * 2, tstepB = 2 * hstepB;
    const unsigned ldsw = (unsigned)wid * 1024u;
    const int aoff = lds_byte(wr * 64 + fr, fq * 8), boff = lds_byte(wc * 32 + fr, fq * 8);
#define PG8_ABASE(u) ((const char*)g.A + (size_t)(u).pm * tstepA + (g.a_mod ? (size_t)(((u).pn >> g.a_shift) % g.a_mod) * g.a_stride * 2 : (size_t)0))
#define PG8_SA(b, h) (((b) * 2 + (h)) * HTB)
#define PG8_SB(b, h) ((4 + (b) * 2 + (h)) * HTB)
#define PG8_STAGE(bufoff, gbase, voff) do { _Pragma("unroll") for (int _i = 0; _i < 2; ++_i) \
        __builtin_amdgcn_global_load_lds((const unsigned*)((const char*)(gbase) + (voff)[_i]), (PG8_LAS unsigned*)(lds + (bufoff) + ldsw + _i * 8192), 16, 0, 0); } while (0)
#define PG8_LDA(dst, b, h) do { _Pragma("unroll") for (int m = 0; m < 4; ++m) _Pragma("unroll") for (int k = 0; k < 2; ++k) dst[m][k] = *(const PG8_LAS bf16x8*)(lds + PG8_SA(b, h) + aoff + m * 2048 + k * 1024); } while (0)
#define PG8_LDB(dst, b, h) do { _Pragma("unroll") for (int n = 0; n < 2; ++n) _Pragma("unroll") for (int k = 0; k < 2; ++k) dst[n][k] = *(const PG8_LAS bf16x8*)(lds + PG8_SB(b, h) + boff + n * 2048 + k * 1024); } while (0)
#define PG8_MMA(ai, bj, At, Bt) do { __builtin_amdgcn_s_setprio(1); _Pragma("unroll") for (int m = 0; m < 4; ++m) _Pragma("unroll") for (int n = 0; n < 2; ++n) _Pragma("unroll") for (int k = 0; k < 2; ++k) \
        acc[ai][bj][m][n] = __builtin_amdgcn_mfma_f32_16x16x32_bf16(Bt[n][k], At[m][k], acc[ai][bj][m][n], 0, 0, 0); __builtin_amdgcn_s_setprio(0); } while (0)
#define PG8_WAIT_V(n) asm volatile("s_waitcnt vmcnt(" #n ")" ::: "memory")
#define PG8_WAIT_L(n) asm volatile("s_waitcnt lgkmcnt(" #n ")" ::: "memory")
#define PG8_BAR __builtin_amdgcn_s_barrier()
#define PG8_SCHED __builtin_amdgcn_sched_barrier(0)
    Unit cur, nxt; int ui = 0;
    if (!S.next(0, cur)) return;
    f32x4 acc[2][2][4][2];
#pragma unroll
    for (int a = 0; a < 2; ++a)
#pragma unroll
        for (int b = 0; b < 2; ++b)
#pragma unroll
            for (int m = 0; m < 4; ++m)
#pragma unroll
                for (int n = 0; n < 2; ++n) acc[a][b][m][n] = (f32x4){0.f, 0.f, 0.f, 0.f};
    bf16x8 At[4][2], B0[2][2], B1[2][2];
    const char* cA = PG8_ABASE(cur); const char* cB = (const char*)g.Bt + (size_t)cur.pn * tstepB;
    S.a_ready(cur);
    if constexpr (SP2) {
        PG8_STAGE(PG8_SB(0, 0), cB, voffB); PG8_STAGE(PG8_SB(0, 1), cB + hstepB, voffB); PG8_STAGE(PG8_SA(0, 0), cA, voffA); PG8_STAGE(PG8_SA(0, 1), cA + hstepA, voffA);
        if (wr == 1) PG8_BAR;
        PG8_WAIT_V(2); PG8_BAR;
        PG8_STAGE(PG8_SB(1, 0), cB + kstep, voffB); PG8_STAGE(PG8_SA(1, 0), cA + kstep, voffA); PG8_STAGE(PG8_SB(1, 1), cB + hstepB + kstep, voffB);
        PG8_WAIT_V(6); PG8_BAR;
    } else {
        PG8_STAGE(PG8_SB(0, 0), cB, voffB); PG8_STAGE(PG8_SA(0, 0), cA, voffA); PG8_STAGE(PG8_SB(0, 1), cB + hstepB, voffB); PG8_STAGE(PG8_SA(0, 1), cA + hstepA, voffA);
        if (wr == 1) PG8_BAR;
        PG8_WAIT_V(4); PG8_BAR;
        PG8_STAGE(PG8_SB(1, 0), cB + kstep, voffB); PG8_STAGE(PG8_SA(1, 0), cA + kstep, voffA); PG8_STAGE(PG8_SB(1, 1), cB + hstepB + kstep, voffB);
        PG8_WAIT_V(6); PG8_BAR;
    }
    for (;;) {
        const bool has_next = S.next(ui + 1, nxt);
        const char* nA = has_next ? PG8_ABASE(nxt) : cA; const char* nB = has_next ? (const char*)g.Bt + (size_t)nxt.pn * tstepB : cB;
#pragma unroll 1
        for (int t = 0; t < nt; t += 2) {
            const bool last = (t == nt - 2);
            const char* a1 = cA + (size_t)(t + 1) * kstep;
            const char* a2 = last ? nA : cA + (size_t)(t + 2) * kstep; const char* b2 = last ? nB : cB + (size_t)(t + 2) * kstep;
            const char* a3 = a2 + kstep; const char* b3 = b2 + kstep;
            if (last && has_next) S.a_ready(nxt);
            if constexpr (SP2) {
            PG8_LDB(B0, 0, 0); PG8_LDB(B1, 0, 1); PG8_SCHED; PG8_LDA(At, 0, 0); PG8_STAGE(PG8_SA(1, 1), a1 + hstepA, voffA);
            PG8_WAIT_V(8); PG8_WAIT_L(0); PG8_BAR; PG8_MMA(0, 0, At, B0); PG8_MMA(0, 1, At, B1); PG8_BAR; PG8_SCHED;
            PG8_LDA(At, 0, 1); PG8_STAGE(PG8_SB(0, 0), b2, voffB); PG8_STAGE(PG8_SB(0, 1), b2 + hstepB, voffB); PG8_STAGE(PG8_SA(0, 0), a2, voffA);
            PG8_WAIT_V(8); PG8_WAIT_L(0); PG8_BAR; PG8_MMA(1, 0, At, B0); PG8_MMA(1, 1, At, B1); PG8_BAR; PG8_SCHED;
            PG8_LDB(B0, 1, 0); PG8_LDB(B1, 1, 1); PG8_SCHED; PG8_LDA(At, 1, 0); PG8_STAGE(PG8_SA(0, 1), a2 + hstepA, voffA);
            PG8_WAIT_V(8); PG8_WAIT_L(0); PG8_BAR; PG8_MMA(0, 0, At, B0); PG8_MMA(0, 1, At, B1); PG8_BAR; PG8_SCHED;
            PG8_LDA(At, 1, 1); PG8_STAGE(PG8_SB(1, 0), b3, voffB); PG8_STAGE(PG8_SB(1, 1), b3 + hstepB, voffB); PG8_STAGE(PG8_SA(1, 0), a3, voffA);
            PG8_WAIT_V(8); PG8_WAIT_L(0); PG8_BAR; PG8_MMA(1, 0, At, B0); PG8_MMA(1, 1, At, B1); PG8_BAR; PG8_SCHED;
            } else {
            PG8_LDB(B0, 0, 0); PG8_SCHED; PG8_LDA(At, 0, 0); PG8_STAGE(PG8_SA(1, 1), a1 + hstepA, voffA);
            PG8_WAIT_L(8); PG8_BAR; PG8_WAIT_L(0); PG8_MMA(0, 0, At, B0); PG8_BAR; PG8_SCHED;
            PG8_LDB(B1, 0, 1); PG8_STAGE(PG8_SB(0, 0), b2, voffB);
            PG8_BAR; PG8_WAIT_L(0); PG8_MMA(0, 1, At, B1); PG8_BAR;
            PG8_LDA(At, 0, 1); PG8_STAGE(PG8_SA(0, 0), a2, voffA);
            PG8_BAR; PG8_WAIT_L(0); PG8_MMA(1, 0, At, B0); PG8_BAR; PG8_SCHED;
            PG8_STAGE(PG8_SB(0, 1), b2 + hstepB, voffB);
            PG8_WAIT_V(6); PG8_BAR; PG8_MMA(1, 1, At, B1); PG8_BAR;
            PG8_LDB(B0, 1, 0); PG8_SCHED; PG8_LDA(At, 1, 0); PG8_STAGE(PG8_SA(0, 1), a2 + hstepA, voffA);
            PG8_WAIT_L(8); PG8_BAR; PG8_WAIT_L(0); PG8_MMA(0, 0, At, B0); PG8_BAR; PG8_SCHED;
            PG8_LDB(B1, 1, 1); PG8_STAGE(PG8_SB(1, 0), b3, voffB);
            PG8_BAR; PG8_WAIT_L(0); PG8_MMA(0, 1, At, B1); PG8_BAR;
            PG8_LDA(At, 1, 1); PG8_STAGE(PG8_SA(1, 0), a3, voffA);
            PG8_BAR; PG8_WAIT_L(0); PG8_MMA(1, 0, At, B0); PG8_BAR; PG8_SCHED;
            PG8_STAGE(PG8_SB(1, 1), b3 + hstepB, voffB);
            PG8_WAIT_V(6); PG8_BAR; PG8_MMA(1, 1, At, B1); PG8_BAR;
            }
        }
        if constexpr (ALIGN_EPI) { if (wr == 0) PG8_BAR; }
        { int l2 = (int)__builtin_amdgcn_mbcnt_hi(~0u, __builtin_amdgcn_mbcnt_lo(~0u, 0u)); asm volatile("" : "+v"(l2));
          E(acc, cur, wr, wc, l2 & 15, l2 >> 4); } S.done(cur);
        if (!has_next) break;
#pragma unroll
        for (int a = 0; a < 2; ++a)
#pragma unroll
            for (int b = 0; b < 2; ++b)
#pragma unroll
                for (int m = 0; m < 4; ++m)
#pragma unroll
                    for (int n = 0; n < 2; ++n) acc[a][b][m][n] = (f32x4){0.f, 0.f, 0.f, 0.f};
        cur = nxt; cA = nA; cB = nB; ++ui;
        if constexpr (ALIGN_EPI) { if (wr == 1) PG8_BAR; }
    }
    PG8_WAIT_V(0);
    if constexpr (!ALIGN_EPI) { if (wr == 0) PG8_BAR; }
    PG8_BAR;
#undef PG8_ABASE
#undef PG8_SA
#undef PG8_SB
#undef PG8_STAGE
#undef PG8_LDA
#undef PG8_LDB
#undef PG8_MMA
#undef PG8_WAIT_V
#undef PG8_WAIT_L
#undef PG8_BAR
#undef PG8_SCHED
}
}

constexpr int NWAVES = 8, NTHR = 512;
constexpr int BATCH = 8, T = 2048, D = 4096, M = BATCH * T;
constexpr int RW = 2048, RPROJ = 6592, SPROJ = 6144, NIN0 = RPROJ + SPROJ  , NIN0P = 10752  , NVT0 = 10688  ;
constexpr int FF = 11008, FF2 = 22016;
constexpr int MH = M / 2;
constexpr float LN_EPS = 1e-5f, LNX_EPS = 64e-5f;
constexpr float DN_ALPHA = 1.41421356237309515f;

#ifndef MK_PER_PHASE
#define MK_PER_PHASE 0
#endif
constexpr int NPHASE = 22;
#ifndef PROBE_MASK
#define PROBE_MASK 0u
#endif

constexpr size_t MiB = 1u << 20;
constexpr size_t WS_CTL = 0, CTL_ZERO_BYTES = 64 * 1024;
constexpr size_t WS_WIN = 2 * MiB, WS_WOUT = 102 * MiB, WS_WUP = 134 * MiB, WS_WDOWN = 306 * MiB, WS_WL1 = 392 * MiB, WS_WG2 = 394 * MiB, WS_WGATES = 395 * MiB;
constexpr size_t WS_A0 = 400 * MiB;
constexpr size_t WS_BIG = 528 * MiB;
constexpr size_t WS_Y = 928 * MiB;
constexpr size_t WS_U = 1056 * MiB;
constexpr size_t WS_SB = 1400 * MiB;
constexpr size_t WS_W1P = 1444 * MiB;
constexpr size_t WS_END = 1734 * MiB;
constexpr int CW_BAR = 4096;

constexpr int RING_OFF = 0, RING_BYTES = 131072;
constexpr int LDSCTL_OFF = RING_BYTES, MISC_OFF = LDSCTL_OFF + 320;
constexpr int LDS_BYTES = 147456;

#define LAS __attribute__((address_space(3)))
typedef unsigned short bf16;
typedef unsigned v4u __attribute__((ext_vector_type(4)));
typedef unsigned v2u __attribute__((ext_vector_type(2)));
typedef float f32x4 __attribute__((ext_vector_type(4)));
#define RLX_AGENT __ATOMIC_RELAXED, __HIP_MEMORY_SCOPE_AGENT
__device__ __forceinline__ unsigned f2bf(float f) { unsigned u = __builtin_bit_cast(unsigned, f); return (u + 0x7fffu + ((u >> 16) & 1u)) >> 16; }
typedef float f32x2_t __attribute__((ext_vector_type(2)));
typedef __bf16 b16x2_t __attribute__((ext_vector_type(2)));
__device__ __forceinline__ unsigned pk2(float lo, float hi) { const f32x2_t v = {lo, hi}; return __builtin_bit_cast(unsigned, __builtin_convertvector(v, b16x2_t)); }
__device__ __forceinline__ float bflo(unsigned w) { return __uint_as_float(w << 16); }
__device__ __forceinline__ float bfhi(unsigned w) { return __uint_as_float(w & 0xffff0000u); }
__device__ __forceinline__ float sigmoidf_(float x) { return __builtin_amdgcn_rcpf(1.0f + __expf(-x)); }
__device__ __forceinline__ float softplusf_(float x) { return fmaxf(x, 0.f) + log1pf(__expf(-fabsf(x))); }

#define XB_TMO      128
#define XB_XCNT(j)  (256  + 64 * (j))
#define XB_XSUB(j)  (1280 + 64 * (j))
#define XB_XGEN(j)  (2304 + 64 * (j))
#define XB_TOP      3328
#define XB_TOPGEN   3392
#define XCD_BAR_WORDS 3456
#define XB_SPIN_CAP (1u << 23)

__device__ __forceinline__ unsigned xb_ld(unsigned* p)              { return __hip_atomic_load(p, __ATOMIC_RELAXED, __HIP_MEMORY_SCOPE_AGENT); }
__device__ __forceinline__ unsigned xb_add(unsigned* p, unsigned v) { return __hip_atomic_fetch_add(p, v, __ATOMIC_RELAXED, __HIP_MEMORY_SCOPE_AGENT); }
__device__ __forceinline__ unsigned xb_xcc_id() { return (unsigned)__builtin_amdgcn_s_getreg((3 << 11) | 20) & 0xFu; }
#define XB_SPIN(cond, bar) do { unsigned _sp = 0; while (cond) { __builtin_amdgcn_s_sleep(1); \
    if ((++_sp & 255u) == 0u) { if (xb_ld(&(bar)[XB_TMO])) break; if (_sp > XB_SPIN_CAP) { atomicAdd(&(bar)[XB_TMO], 1u); break; } } } } while (0)

struct XcdBarrier {
    unsigned* bar; unsigned x;
    volatile LAS unsigned* st;
};
__device__ __forceinline__ XcdBarrier xcd_barrier_post(unsigned* bar, volatile LAS unsigned* st) {
    XcdBarrier b; b.bar = bar; b.x = xb_xcc_id(); b.st = st;
    if (threadIdx.x == 0) (void)xb_add(&bar[XB_XCNT(b.x)], 1u);
    return b;
}
__device__ __forceinline__ void xcd_barrier_complete(unsigned* bar, unsigned x, unsigned& nloc, unsigned& nx) {
    const unsigned G = gridDim.x * gridDim.y * gridDim.z;
    unsigned sum, cnt, mine, sp = 0u;
    for (;;) {
        sum = 0u; cnt = 0u; mine = 0u;
#pragma unroll
        for (unsigned j = 0; j < 16; ++j) { const unsigned c = xb_ld(&bar[XB_XCNT(j)]); sum += c; cnt += (c > 0u) ? 1u : 0u; mine = (j == x) ? c : mine; }
        if (sum == G) break;
        __builtin_amdgcn_s_sleep(1);
        if ((++sp & 255u) == 0u) { if (xb_ld(&bar[XB_TMO])) break; if (sp > XB_SPIN_CAP) { atomicAdd(&bar[XB_TMO], 1u); break; } }
    }
    nloc = mine > 0u ? mine : 1u; nx = cnt > 0u ? cnt : 1u;
}
__device__ __forceinline__ void xcd_barrier(const XcdBarrier& b) {
    asm volatile("s_waitcnt vmcnt(0)" ::: "memory");
    __syncthreads();
    if (threadIdx.x == 0) {
        unsigned* bar = b.bar;
        __builtin_amdgcn_s_waitcnt(0);
        unsigned nloc = b.st[0], nx = b.st[1];
        if (nloc == 0u) { xcd_barrier_complete(bar, b.x, nloc, nx); b.st[0] = nloc; b.st[1] = nx; }
        const unsigned old = xb_add(&bar[XB_XSUB(b.x)], 1u);
        const unsigned gen = old / nloc;
        if (old + 1u == (gen + 1u) * nloc) {
            __builtin_amdgcn_fence(__ATOMIC_RELEASE, "agent");
            asm volatile("s_waitcnt vmcnt(0)" ::: "memory");
            const unsigned og = xb_add(&bar[XB_TOP], 1u);
            const unsigned tg = og / nx;
            if (og + 1u == (tg + 1u) * nx) xb_add(&bar[XB_TOPGEN], 1u);
            else XB_SPIN(xb_ld(&bar[XB_TOPGEN]) == tg, bar);
            __builtin_amdgcn_fence(__ATOMIC_ACQUIRE, "agent");
            xb_add(&bar[XB_XGEN(b.x)], 1u);
            asm volatile("s_waitcnt vmcnt(0)" ::: "memory");
        } else {
            XB_SPIN(xb_ld(&bar[XB_XGEN(b.x)]) == gen, bar);
            __builtin_amdgcn_fence(__ATOMIC_ACQUIRE, "agent");
            asm volatile("s_waitcnt vmcnt(0)" ::: "memory");
        }
    }
    __syncthreads();
}

#define LB_BASE   8192
#define LB_CNT(c) (LB_BASE + 64 * (c))
#define LB_GEN(c) (LB_BASE + 1024 + 64 * (c))
#define LB_MAP(c) (LB_BASE + 2048 + 64 * (c))
__device__ __forceinline__ void xcd_local_barrier(unsigned* ctl, unsigned* bar, int chunk, unsigned nloc) {
    asm volatile("s_waitcnt vmcnt(0)" ::: "memory");
    __syncthreads();
    if (threadIdx.x == 0) {
        const unsigned old = xb_add(&ctl[LB_CNT(chunk)], 1u);
        const unsigned gen = old / nloc;
        if (old + 1u == (gen + 1u) * nloc) xb_add(&ctl[LB_GEN(chunk)], 1u);
        else XB_SPIN(xb_ld(&ctl[LB_GEN(chunk)]) == gen, bar);
        __builtin_amdgcn_fence(__ATOMIC_ACQUIRE, "agent");
        asm volatile("s_waitcnt vmcnt(0)" ::: "memory");
    }
    __syncthreads();
}

__device__ __forceinline__ void transpose_item(const float* W, int K, int N, bf16* WT, int row_off, LAS float* scr, int item, int lane) {
    const int nblk = N / 32, kb = item / nblk, nb = item % nblk, k0 = 64 * kb, n0 = 32 * nb;
#pragma unroll 8
    for (int i = 0; i < 32; ++i) { const int kk = 2 * i + (lane >> 5); scr[kk * 33 + (lane & 31)] = W[(size_t)(k0 + kk) * N + n0 + (lane & 31)]; }
    asm volatile("s_waitcnt lgkmcnt(0)" ::: "memory");
    const int c = lane & 7;
#pragma unroll
    for (int j = 0; j < 4; ++j) { const int n = (lane >> 3) + 8 * j; const LAS float* s = scr + (8 * c) * 33 + n;
        v4u o; o.x = pk2(s[0 * 33], s[1 * 33]); o.y = pk2(s[2 * 33], s[3 * 33]); o.z = pk2(s[4 * 33], s[5 * 33]); o.w = pk2(s[6 * 33], s[7 * 33]);
        *(v4u*)(WT + (size_t)(row_off + n0 + n) * K + k0 + 8 * c) = o; }
    asm volatile("s_waitcnt lgkmcnt(0)" ::: "memory");
}
__device__ __forceinline__ float wave_sum(float v) {
#pragma unroll
    for (int o = 1; o < 64; o <<= 1) v += __shfl_xor(v, o);
    return v;
}
template <int CTRL> __device__ __forceinline__ float dpp_x(float v) { return __builtin_bit_cast(float, __builtin_amdgcn_update_dpp(0, __builtin_bit_cast(int, v), CTRL, 0xF, 0xF, true)); }
__device__ __forceinline__ float wave_sum_fast(float v) {
    v += dpp_x<0xB1>(v); v += dpp_x<0x4E>(v); v += dpp_x<0x141>(v); v += dpp_x<0x140>(v);
    v += __shfl_xor(v, 16); v += __shfl_xor(v, 32);
    return v;
}
__device__ __forceinline__ void ln_load(f32x4 (&v)[16], const float* src, int lane) {
    const f32x4* xr = (const f32x4*)src + lane;
#pragma unroll
    for (int j = 0; j < 16; ++j) v[j] = xr[64 * j];
}
__device__ __forceinline__ void ln_finish(f32x4 (&v)[16], const float* g, const float* bta, float* dstf, bf16* dstb, float* st, int lane) {
    float s = 0.f;
#pragma unroll
    for (int j = 0; j < 16; ++j) s += (v[j].x + v[j].y) + (v[j].z + v[j].w);
    const float mean = wave_sum_fast(s) * (1.f / D); float s2 = 0.f;
#pragma unroll
    for (int j = 0; j < 16; ++j) { v[j] = v[j] - mean; s2 += (v[j].x * v[j].x + v[j].y * v[j].y) + (v[j].z * v[j].z + v[j].w * v[j].w); }
    const float rstd = 1.f / sqrtf(wave_sum_fast(s2) * (1.f / D) + LN_EPS);
    if (st && lane == 0) { st[0] = mean; st[1] = rstd; }
#pragma unroll
    for (int j = 0; j < 16; ++j) {
        const f32x4 gg = ((const f32x4*)g)[lane + 64 * j], bb = ((const f32x4*)bta)[lane + 64 * j];
        const f32x4 o = v[j] * rstd * gg + bb;
        if (dstf) ((f32x4*)dstf)[lane + 64 * j] = o;
        if (dstb) { v2u w; w.x = pk2(o.x, o.y); w.y = pk2(o.z, o.w); ((v2u*)dstb)[lane + 64 * j] = w; }
    }
}
__device__ __forceinline__ void ln_load_b(f32x4 (&v)[16], const bf16* src, int lane) {
    const v4u* xr = (const v4u*)src + lane;
#pragma unroll
    for (int j = 0; j < 8; ++j) { const v4u w = xr[64 * j];
        v[2 * j] = (f32x4){bflo(w.x), bfhi(w.x), bflo(w.y), bfhi(w.y)}; v[2 * j + 1] = (f32x4){bflo(w.z), bfhi(w.z), bflo(w.w), bfhi(w.w)}; }
}
__device__ __forceinline__ void ln_finish_b(f32x4 (&v)[16], const float* g, const float* bta, bf16* dstb, float* st, int lane) {
    float s = 0.f;
#pragma unroll
    for (int j = 0; j < 16; ++j) s += (v[j].x + v[j].y) + (v[j].z + v[j].w);
    const float mean = wave_sum_fast(s) * (1.f / D); float s2 = 0.f;
#pragma unroll
    for (int j = 0; j < 16; ++j) { v[j] = v[j] - mean; s2 += (v[j].x * v[j].x + v[j].y * v[j].y) + (v[j].z * v[j].z + v[j].w * v[j].w); }
    const float rstd = 1.f / sqrtf(wave_sum_fast(s2) * (1.f / D) + LN_EPS);
    if (lane == 0) { st[0] = mean; st[1] = rstd; }
#pragma unroll
    for (int j = 0; j < 8; ++j) {
        const int c = 8 * (lane + 64 * j);
        const f32x4 ga = *(const f32x4*)(g + c), gb = *(const f32x4*)(g + c + 4), ba = *(const f32x4*)(bta + c), bb = *(const f32x4*)(bta + c + 4);
        const f32x4 oa = v[2 * j] * rstd * ga + ba, ob = v[2 * j + 1] * rstd * gb + bb;
        v4u w; w.x = pk2(oa.x, oa.y); w.y = pk2(oa.z, oa.w); w.z = pk2(ob.x, ob.y); w.w = pk2(ob.z, ob.w);
        ((v4u*)dstb)[lane + 64 * j] = w;
    }
}
__device__ __forceinline__ void ln_rows_b(const bf16* S, const float* g, const float* bta, bf16* dstb, float* st, int m0, int mstride, int mend, int lane) {
    f32x4 va[16], vb[16];
    int m = m0; if (m >= mend) return;
    ln_load_b(va, S + (size_t)m * D, lane);
    for (;;) {
        const int m2 = m + mstride;
        if (m2 < mend) ln_load_b(vb, S + (size_t)m2 * D, lane);
        ln_finish_b(va, g, bta, dstb + (size_t)m * D, st + 2 * (size_t)m, lane);
        if (m2 >= mend) break;
        const int m3 = m2 + mstride;
        if (m3 < mend) ln_load_b(va, S + (size_t)m3 * D, lane);
        ln_finish_b(vb, g, bta, dstb + (size_t)m2 * D, st + 2 * (size_t)m2, lane);
        if (m3 >= mend) break;
        m = m3;
    }
}
__device__ __forceinline__ void ln_finish_bf(f32x4 (&v)[16], const float* g, const float* bta, float* dstf, int lane) {
    float s = 0.f;
#pragma unroll
    for (int j = 0; j < 16; ++j) s += (v[j].x + v[j].y) + (v[j].z + v[j].w);
    const float mean = wave_sum_fast(s) * (1.f / D); float s2 = 0.f;
#pragma unroll
    for (int j = 0; j < 16; ++j) { v[j] = v[j] - mean; s2 += (v[j].x * v[j].x + v[j].y * v[j].y) + (v[j].z * v[j].z + v[j].w * v[j].w); }
    const float rstd = 1.f / sqrtf(wave_sum_fast(s2) * (1.f / D) + LN_EPS);
#pragma unroll
    for (int j = 0; j < 8; ++j) {
        const int c = 8 * (lane + 64 * j);
        const f32x4 ga = *(const f32x4*)(g + c), gb = *(const f32x4*)(g + c + 4), ba = *(const f32x4*)(bta + c), bb = *(const f32x4*)(bta + c + 4);
        __builtin_nontemporal_store(v[2 * j] * rstd * ga + ba, (f32x4*)(dstf + c)); __builtin_nontemporal_store(v[2 * j + 1] * rstd * gb + bb, (f32x4*)(dstf + c + 4));
    }
}
__device__ __forceinline__ void ln_rows_bf(const bf16* S, const float* g, const float* bta, float* dst, int m0, int mstride, int mend, int lane) {
    f32x4 va[16], vb[16];
    int m = m0; if (m >= mend) return;
    ln_load_b(va, S + (size_t)m * D, lane);
    for (;;) {
        const int m2 = m + mstride;
        if (m2 < mend) ln_load_b(vb, S + (size_t)m2 * D, lane);
        ln_finish_bf(va, g, bta, dst + (size_t)m * D, lane);
        if (m2 >= mend) break;
        const int m3 = m2 + mstride;
        if (m3 < mend) ln_load_b(va, S + (size_t)m3 * D, lane);
        ln_finish_bf(vb, g, bta, dst + (size_t)m2 * D, lane);
        if (m3 >= mend) break;
        m = m3;
    }
}
__device__ __forceinline__ void ln_rows(const float* S, const float* g, const float* bta, float* dstf, bf16* dstb, float* st, int m0, int mstride, int mend, int lane) {
    f32x4 va[16], vb[16];
    int m = m0; if (m >= mend) return;
    ln_load(va, S + (size_t)m * D, lane);
    for (;;) {
        const int m2 = m + mstride;
        if (m2 < mend) ln_load(vb, S + (size_t)m2 * D, lane);
        ln_finish(va, g, bta, dstf ? dstf + (size_t)m * D : nullptr, dstb ? dstb + (size_t)m * D : nullptr, st ? st + 2 * (size_t)m : nullptr, lane);
        if (m2 >= mend) break;
        const int m3 = m2 + mstride;
        if (m3 < mend) ln_load(va, S + (size_t)m3 * D, lane);
        ln_finish(vb, g, bta, dstf ? dstf + (size_t)m2 * D : nullptr, dstb ? dstb + (size_t)m2 * D : nullptr, st ? st + 2 * (size_t)m2 : nullptr, lane);
        if (m3 >= mend) break;
        m = m3;
    }
}
__device__ __forceinline__ void unpack8(const v4u w, float (&f)[8]) {
    f[0] = bflo(w.x); f[1] = bfhi(w.x); f[2] = bflo(w.y); f[3] = bfhi(w.y); f[4] = bflo(w.z); f[5] = bfhi(w.z); f[6] = bflo(w.w); f[7] = bfhi(w.w);
}
__device__ __forceinline__ v4u pack8(const float (&f)[8]) { v4u w; w.x = pk2(f[0], f[1]); w.y = pk2(f[2], f[3]); w.z = pk2(f[4], f[5]); w.w = pk2(f[6], f[7]); return w; }

struct Args { const float* in[39]; float* out; unsigned char* ws; int ph_lo, ph_hi; };


template <int CTRL> __device__ __forceinline__ float dpp_f(float v) { return __builtin_bit_cast(float, __builtin_amdgcn_update_dpp(0, __builtin_bit_cast(int, v), CTRL, 0xF, 0xF, true)); }
__device__ __forceinline__ float row16_sum(float v) {
    v += dpp_f<0xB1>(v);
    v += dpp_f<0x4E>(v);
    v += dpp_f<0x141>(v);
    v += dpp_f<0x140>(v);
    return v;
}


constexpr int CV_OUT = 64 * 64, CV_UP = 64 * 344, CV_DOWN = 172 * 64, CV_LAYER = CV_OUT + CV_UP + CV_DOWN, CV_FULL = 2 * CV_LAYER, CV_TOTAL = 2 * CV_FULL;
struct CvtDesc { const float* src; bf16* dst; int N, K; };
__device__ __forceinline__ CvtDesc cvt_desc(const Args& a, int hit, int lane) {
    const int it = hit >> 1, hf = hit & 1;
    const int L = it >= CV_LAYER; int r = it - L * CV_LAYER;
    unsigned char* wsb = a.ws;
    CvtDesc d;
    if (r < CV_OUT) { const int kb = r >> 6, nb = r & 63; d.N = D; d.K = D; d.src = (L ? a.in[30] : a.in[13]) + (size_t)(64 * kb) * D + 64 * nb + lane;
        d.dst = (bf16*)(wsb + (L ? WS_W1P : WS_WOUT)) + (size_t)(64 * nb + lane) * D + 64 * kb; d.src += (size_t)(32 * hf) * d.N; d.dst += 32 * hf; return d; }
    r -= CV_OUT;
    if (r < CV_UP) { const int kb = r / 344, nb = r - kb * 344, n0 = 64 * nb; const int row = n0 < FF ? 256 * (n0 >> 7) + (n0 & 127) : 256 * ((n0 - FF) >> 7) + 128 + ((n0 - FF) & 127);
        d.N = FF2; d.K = D; d.src = (L ? a.in[33] : a.in[16]) + (size_t)(64 * kb) * FF2 + n0 + lane;
        d.dst = (bf16*)(wsb + (L ? WS_W1P + 32 * MiB : WS_WUP)) + (size_t)(row + lane) * D + 64 * kb; d.src += (size_t)(32 * hf) * d.N; d.dst += 32 * hf; return d; }
    r -= CV_UP;
    { const int kb = r >> 6, nb = r & 63; d.N = D; d.K = FF; d.src = (L ? a.in[36] : a.in[19]) + (size_t)(64 * kb) * D + 64 * nb + lane;
      d.dst = (bf16*)(wsb + (L ? WS_W1P + 204 * MiB : WS_WDOWN)) + (size_t)(64 * nb + lane) * FF + 64 * kb; d.src += (size_t)(32 * hf) * d.N; d.dst += 32 * hf; return d; }
}
__device__ __forceinline__ void cvt_load(float (&v)[32], const CvtDesc& d) {
#pragma unroll
    for (int k = 0; k < 32; ++k) v[k] = d.src[(size_t)k * d.N];
}
__device__ __forceinline__ void cvt_store(const float (&v)[32], const CvtDesc& d) {
#pragma unroll
    for (int q = 0; q < 4; ++q) { v4u o; o.x = pk2(v[8 * q], v[8 * q + 1]); o.y = pk2(v[8 * q + 2], v[8 * q + 3]); o.z = pk2(v[8 * q + 4], v[8 * q + 5]); o.w = pk2(v[8 * q + 6], v[8 * q + 7]); ((v4u*)d.dst)[q] = o; }
}

__device__ __forceinline__ void row16_sum4(float& a, float& b, float& c, float& d) {
    asm volatile("s_nop 1\n\t"
        "v_add_f32_dpp %0, %0, %0 quad_perm:[1,0,3,2] row_mask:0xf bank_mask:0xf bound_ctrl:1\n\t"
        "v_add_f32_dpp %1, %1, %1 quad_perm:[1,0,3,2] row_mask:0xf bank_mask:0xf bound_ctrl:1\n\t"
        "v_add_f32_dpp %2, %2, %2 quad_perm:[1,0,3,2] row_mask:0xf bank_mask:0xf bound_ctrl:1\n\t"
        "v_add_f32_dpp %3, %3, %3 quad_perm:[1,0,3,2] row_mask:0xf bank_mask:0xf bound_ctrl:1\n\t"
        "v_add_f32_dpp %0, %0, %0 quad_perm:[2,3,0,1] row_mask:0xf bank_mask:0xf bound_ctrl:1\n\t"
        "v_add_f32_dpp %1, %1, %1 quad_perm:[2,3,0,1] row_mask:0xf bank_mask:0xf bound_ctrl:1\n\t"
        "v_add_f32_dpp %2, %2, %2 quad_perm:[2,3,0,1] row_mask:0xf bank_mask:0xf bound_ctrl:1\n\t"
        "v_add_f32_dpp %3, %3, %3 quad_perm:[2,3,0,1] row_mask:0xf bank_mask:0xf bound_ctrl:1\n\t"
        "v_add_f32_dpp %0, %0, %0 row_half_mirror row_mask:0xf bank_mask:0xf bound_ctrl:1\n\t"
        "v_add_f32_dpp %1, %1, %1 row_half_mirror row_mask:0xf bank_mask:0xf bound_ctrl:1\n\t"
        "v_add_f32_dpp %2, %2, %2 row_half_mirror row_mask:0xf bank_mask:0xf bound_ctrl:1\n\t"
        "v_add_f32_dpp %3, %3, %3 row_half_mirror row_mask:0xf bank_mask:0xf bound_ctrl:1\n\t"
        "v_add_f32_dpp %0, %0, %0 row_mirror row_mask:0xf bank_mask:0xf bound_ctrl:1\n\t"
        "v_add_f32_dpp %1, %1, %1 row_mirror row_mask:0xf bank_mask:0xf bound_ctrl:1\n\t"
        "v_add_f32_dpp %2, %2, %2 row_mirror row_mask:0xf bank_mask:0xf bound_ctrl:1\n\t"
        "v_add_f32_dpp %3, %3, %3 row_mirror row_mask:0xf bank_mask:0xf bound_ctrl:1\n\t"
        "s_nop 0"
        : "+v"(a), "+v"(b), "+v"(c), "+v"(d));
}
__device__ __forceinline__ void row8_sum4(float& a, float& b, float& c, float& d) {
    asm volatile("s_nop 1\n\t"
        "v_add_f32_dpp %0, %0, %0 quad_perm:[1,0,3,2] row_mask:0xf bank_mask:0xf bound_ctrl:1\n\t"
        "v_add_f32_dpp %1, %1, %1 quad_perm:[1,0,3,2] row_mask:0xf bank_mask:0xf bound_ctrl:1\n\t"
        "v_add_f32_dpp %2, %2, %2 quad_perm:[1,0,3,2] row_mask:0xf bank_mask:0xf bound_ctrl:1\n\t"
        "v_add_f32_dpp %3, %3, %3 quad_perm:[1,0,3,2] row_mask:0xf bank_mask:0xf bound_ctrl:1\n\t"
        "v_add_f32_dpp %0, %0, %0 quad_perm:[2,3,0,1] row_mask:0xf bank_mask:0xf bound_ctrl:1\n\t"
        "v_add_f32_dpp %1, %1, %1 quad_perm:[2,3,0,1] row_mask:0xf bank_mask:0xf bound_ctrl:1\n\t"
        "v_add_f32_dpp %2, %2, %2 quad_perm:[2,3,0,1] row_mask:0xf bank_mask:0xf bound_ctrl:1\n\t"
        "v_add_f32_dpp %3, %3, %3 quad_perm:[2,3,0,1] row_mask:0xf bank_mask:0xf bound_ctrl:1\n\t"
        "v_add_f32_dpp %0, %0, %0 row_half_mirror row_mask:0xf bank_mask:0xf bound_ctrl:1\n\t"
        "v_add_f32_dpp %1, %1, %1 row_half_mirror row_mask:0xf bank_mask:0xf bound_ctrl:1\n\t"
        "v_add_f32_dpp %2, %2, %2 row_half_mirror row_mask:0xf bank_mask:0xf bound_ctrl:1\n\t"
        "v_add_f32_dpp %3, %3, %3 row_half_mirror row_mask:0xf bank_mask:0xf bound_ctrl:1\n\t"
        "s_nop 0"
        : "+v"(a), "+v"(b), "+v"(c), "+v"(d));
}
constexpr int RCH = 16, RVEC = 5 * RCH * 64, RV1 = RCH * 64;
struct RwkvStepIn { f32x2_t kk[4], wr[4], w[4], b[4], k[4]; f32x2_t vv, sc; };
__device__ __forceinline__ void rwkv_ld(RwkvStepIn& x, const LAS float* VEC, const LAS float* VV, const LAS float* SC, int i, int kq, int vrow) {
    const LAS f32x4* q0 = (const LAS f32x4*)(VEC + i * 64 + 8 * kq);
    const f32x4 a0 = q0[0], a1 = q0[1], b0 = q0[RV1 / 4], b1 = q0[RV1 / 4 + 1], c0 = q0[2 * RV1 / 4], c1 = q0[2 * RV1 / 4 + 1], d0 = q0[3 * RV1 / 4], d1 = q0[3 * RV1 / 4 + 1], e0 = q0[4 * RV1 / 4], e1 = q0[4 * RV1 / 4 + 1];
    x.kk[0] = (f32x2_t){a0[0], a0[1]}; x.kk[1] = (f32x2_t){a0[2], a0[3]}; x.kk[2] = (f32x2_t){a1[0], a1[1]}; x.kk[3] = (f32x2_t){a1[2], a1[3]};
    x.wr[0] = (f32x2_t){b0[0], b0[1]}; x.wr[1] = (f32x2_t){b0[2], b0[3]}; x.wr[2] = (f32x2_t){b1[0], b1[1]}; x.wr[3] = (f32x2_t){b1[2], b1[3]};
    x.w[0] = (f32x2_t){c0[0], c0[1]}; x.w[1] = (f32x2_t){c0[2], c0[3]}; x.w[2] = (f32x2_t){c1[0], c1[1]}; x.w[3] = (f32x2_t){c1[2], c1[3]};
    x.b[0] = (f32x2_t){d0[0], d0[1]}; x.b[1] = (f32x2_t){d0[2], d0[3]}; x.b[2] = (f32x2_t){d1[0], d1[1]}; x.b[3] = (f32x2_t){d1[2], d1[3]};
    x.k[0] = (f32x2_t){e0[0], e0[1]}; x.k[1] = (f32x2_t){e0[2], e0[3]}; x.k[2] = (f32x2_t){e1[0], e1[1]}; x.k[3] = (f32x2_t){e1[2], e1[3]};
    x.vv = *(const LAS f32x2_t*)(VV + i * 64 + vrow); x.sc = *(const LAS f32x2_t*)(SC + 4 * i);
}
__device__ __forceinline__ void rwkv_step(const RwkvStepIn& x, f32x2_t (&s0)[4], f32x2_t (&s1)[4], LAS float* YY, int i, int kq, int vrow) {
    f32x2_t pa = s0[0] * x.kk[0], pb = s1[0] * x.kk[0], pc = s0[0] * x.wr[0], pd = s1[0] * x.wr[0];
#pragma unroll
    for (int q = 1; q < 4; ++q) { pa = s0[q] * x.kk[q] + pa; pb = s1[q] * x.kk[q] + pb; pc = s0[q] * x.wr[q] + pc; pd = s1[q] * x.wr[q] + pd; }
    float psa0 = pa[0] + pa[1], psa1 = pb[0] + pb[1], py0 = pc[0] + pc[1], py1 = pd[0] + pd[1];
    row8_sum4(psa0, psa1, py0, py1);
    const f32x2_t na0 = (f32x2_t){-psa0, -psa0}, na1 = (f32x2_t){-psa1, -psa1}, v0 = (f32x2_t){x.vv[0], x.vv[0]}, v1 = (f32x2_t){x.vv[1], x.vv[1]};
#pragma unroll
    for (int q = 0; q < 4; ++q) { s0[q] = s0[q] * x.w[q] + x.b[q] * na0 + x.k[q] * v0; s1[q] = s1[q] * x.w[q] + x.b[q] * na1 + x.k[q] * v1; }
    f32x2_t yo; yo[0] = py0 - psa0 * x.sc[0] + x.vv[0] * x.sc[1]; yo[1] = py1 - psa1 * x.sc[0] + x.vv[1] * x.sc[1];
    if (kq == 0) *(LAS f32x2_t*)(YY + i * 64 + vrow) = yo;
}
struct RwkvTok { v2u r1, k1, v1, r0, k0, v0, gw; f32x4 wpre, apre; };
__device__ __forceinline__ void rwkv_gld(RwkvTok& g, const bf16* p, const float* wa, const bf16* gbuf, size_t m, int t, int hc) {
    const bf16* prow = p + m * NIN0P + hc;
    g.r1 = *(const v2u*)(prow); g.k1 = *(const v2u*)(prow + 2048); g.v1 = *(const v2u*)(prow + 4096);
    g.r0 = (v2u){0u, 0u}; g.k0 = g.r0; g.v0 = g.r0;
    if (t > 0) { g.r0 = *(const v2u*)(prow - NIN0P); g.k0 = *(const v2u*)(prow - NIN0P + 2048); g.v0 = *(const v2u*)(prow - NIN0P + 4096); }
    g.wpre = *(const f32x4*)(wa + m * 4096 + hc); g.apre = *(const f32x4*)(wa + m * 4096 + 2048 + hc);
    g.gw = *(const v2u*)(gbuf + m * 2048 + hc);
}
struct RwkvPar { f32x4 mu_r, mu_k, mu_v, dbase, ibase, kkp, kap, rkp, lg, lb; };
__device__ __forceinline__ f32x4 rwkv_prep(const RwkvTok& g, const RwkvPar& P, LAS float* VEC, LAS float* VV, LAS float* SC, int tok, int cq) {
    const f32x4 rc = (f32x4){bflo(g.r1.x), bfhi(g.r1.x), bflo(g.r1.y), bfhi(g.r1.y)}, rpv = (f32x4){bflo(g.r0.x), bfhi(g.r0.x), bflo(g.r0.y), bfhi(g.r0.y)};
    const f32x4 kc = (f32x4){bflo(g.k1.x), bfhi(g.k1.x), bflo(g.k1.y), bfhi(g.k1.y)}, kp = (f32x4){bflo(g.k0.x), bfhi(g.k0.x), bflo(g.k0.y), bfhi(g.k0.y)};
    const f32x4 vc = (f32x4){bflo(g.v1.x), bfhi(g.v1.x), bflo(g.v1.y), bfhi(g.v1.y)}, vp = (f32x4){bflo(g.v0.x), bfhi(g.v0.x), bflo(g.v0.y), bfhi(g.v0.y)};
    const f32x4 rr = rc + (rpv - rc) * P.mu_r, kx = kc + (kp - kc) * P.mu_k, vx = vc + (vp - vc) * P.mu_v;
    f32x4 dec, av, kkr, k2; float ss = 0.f;
#pragma unroll
    for (int j = 0; j < 4; ++j) {
        const float zw = P.dbase[j] + g.wpre[j];
        dec[j] = __expf(-0.60653065971263342f * sigmoidf_(zw));
        av[j] = sigmoidf_(P.ibase[j] + g.apre[j]);
        kkr[j] = kx[j] * P.kkp[j]; ss += kkr[j] * kkr[j];
        k2[j] = kx[j] * (1.0f + (av[j] - 1.0f) * P.kap[j]);
    }
    ss = row16_sum(ss);
    const float inv = __builtin_amdgcn_rsqf(fmaxf(ss, 1e-24f));
    const f32x4 kkn = kkr * inv, bb = kkn * av, wr = dec * rr;
    float br = 0.f, kr = 0.f, bon = 0.f, dmy = 0.f;
#pragma unroll
    for (int j = 0; j < 4; ++j) { br += bb[j] * rr[j]; kr += k2[j] * rr[j]; bon += rr[j] * k2[j] * P.rkp[j]; }
    row16_sum4(br, kr, bon, dmy);
    const int o = tok * 64 + 4 * cq;
    *(LAS f32x4*)(VEC + 0 * RV1 + o) = kkn; *(LAS f32x4*)(VEC + 1 * RV1 + o) = wr; *(LAS f32x4*)(VEC + 2 * RV1 + o) = dec;
    *(LAS f32x4*)(VEC + 3 * RV1 + o) = bb;  *(LAS f32x4*)(VEC + 4 * RV1 + o) = k2; *(LAS f32x4*)(VV + o) = vx;
    if (cq == 0) *(LAS f32x2_t*)(SC + 4 * tok) = (f32x2_t){br, kr};
    return vx * bon;
}
__device__ __forceinline__ void rwkv_post(const LAS float* YY, const f32x4 pv, const v2u gw, const RwkvPar& P, bf16* yout, int tok, int cq) {
    const f32x4 y4 = *(const LAS f32x4*)(YY + tok * 64 + 4 * cq);
    float s1_ = (y4[0] + y4[1]) + (y4[2] + y4[3]);
    s1_ = row16_sum(s1_);
    const float mean = s1_ * (1.f / 64.f); const f32x4 d = y4 - mean;
    float s2 = (d[0] * d[0] + d[1] * d[1]) + (d[2] * d[2] + d[3] * d[3]);
    s2 = row16_sum(s2);
    const float rstd = __builtin_amdgcn_rsqf(s2 * (1.f / 64.f) + LNX_EPS);
    const f32x4 gv = (f32x4){bflo(gw.x), bfhi(gw.x), bflo(gw.y), bfhi(gw.y)};
    const f32x4 res = (d * rstd * P.lg + P.lb + pv) * gv;
    v2u ow; ow.x = pk2(res[0], res[1]); ow.y = pk2(res[2], res[3]);
    *(v2u*)(yout) = ow;
}
__device__ __forceinline__ void rwkv_head(const Args& a, LAS float* L, int bh, const bf16* p, const float* wa, const bf16* gbuf, bf16* Y, bool do_cvt, int cvt_j0) {
    const int tid = threadIdx.x, lane = tid & 63, w = __builtin_amdgcn_readfirstlane(tid >> 6);
    const int b = bh >> 5, h = bh & 31;
    LAS float* VEC = L; LAS float* VV = L + 2 * RVEC; LAS float* SC = VV + 2 * RV1; LAS float* YY = SC + 2 * RCH * 4;
    constexpr int NCH = T / RCH;
    if (w < 4) {
        const int rp = lane >> 3, kq = lane & 7, vrow = 16 * w + 2 * rp;
        f32x2_t s0[4], s1[4];
#pragma unroll
        for (int q = 0; q < 4; ++q) { s0[q] = (f32x2_t){0.f, 0.f}; s1[q] = s0[q]; }
        __syncthreads();
#pragma unroll 1
        for (int c = 0; c < NCH; ++c) {
            const LAS float* vec = VEC + (c & 1) * RVEC; const LAS float* vv = VV + (c & 1) * RV1; const LAS float* sc = SC + (c & 1) * RCH * 4; LAS float* yy = YY + (c & 1) * RV1;
            RwkvStepIn xa, xb;
            rwkv_ld(xa, vec, vv, sc, 0, kq, vrow);
#pragma unroll 1
            for (int i = 0; i < RCH; i += 2) {
                rwkv_ld(xb, vec, vv, sc, i + 1, kq, vrow);
                rwkv_step(xa, s0, s1, yy, i, kq, vrow);
                rwkv_ld(xa, vec, vv, sc, (i + 2) & (RCH - 1), kq, vrow);
                rwkv_step(xb, s0, s1, yy, i + 1, kq, vrow);
            }
            __syncthreads();
        }
    } else {
        const int at = tid - 256, tok = at >> 4, cq = at & 15, hc = h * 64 + 4 * cq;
        RwkvPar P;
        P.mu_r = *(const f32x4*)(a.in[2] + hc); P.mu_k = *(const f32x4*)(a.in[2] + 2048 + hc); P.mu_v = *(const f32x4*)(a.in[2] + 4096 + hc);
        P.dbase = *(const f32x4*)(a.in[3] + hc); P.ibase = *(const f32x4*)(a.in[5] + hc); P.kkp = *(const f32x4*)(a.in[8] + hc); P.kap = *(const f32x4*)(a.in[9] + hc);
        P.rkp = *(const f32x4*)(a.in[10] + hc); P.lg = *(const f32x4*)(a.in[11] + hc); P.lb = *(const f32x4*)(a.in[12] + hc);
        const size_t mb = (size_t)b * T + tok;
        RwkvTok g0, g1; rwkv_gld(g0, p, wa, gbuf, mb, tok, hc);
        f32x4 pvA = (f32x4){0.f, 0.f, 0.f, 0.f}, pvB = rwkv_prep(g0, P, VEC, VV, SC, tok, cq);
        v2u gwA = (v2u){0u, 0u}, gwB = g0.gw;
        rwkv_gld(g1, p, wa, gbuf, mb + RCH, tok + RCH, hc);
        rwkv_gld(g0, p, wa, gbuf, mb + 2 * RCH, tok + 2 * RCH, hc);
        const int aw = blockIdx.x * 4 + (w - 4), astride = gridDim.x * 4;
        float cvb[32]; int cpend = -1;
        __syncthreads();
#pragma unroll 1
        for (int c = 0; c < NCH; ++c) {
            if (do_cvt) {
                if (cpend >= 0) { const CvtDesc dd = cvt_desc(a, cpend, lane); cvt_store(cvb, dd); }
                const int itn = aw + (cvt_j0 + c) * astride;
                if (itn < CV_TOTAL) { const CvtDesc dd = cvt_desc(a, itn, lane); cvt_load(cvb, dd); cpend = itn; } else cpend = -1;
            }
            f32x4 pvN = pvB; v2u gwN = gwB;
            if (c + 1 < NCH) {
                const int bf = (c + 1) & 1;
                if (bf) { pvN = rwkv_prep(g1, P, VEC + RVEC, VV + RV1, SC + RCH * 4, tok, cq); gwN = g1.gw;
                          if (c + 3 < NCH) rwkv_gld(g1, p, wa, gbuf, mb + (size_t)(c + 3) * RCH, tok + (c + 3) * RCH, hc); }
                else    { pvN = rwkv_prep(g0, P, VEC, VV, SC, tok, cq); gwN = g0.gw;
                          if (c + 3 < NCH) rwkv_gld(g0, p, wa, gbuf, mb + (size_t)(c + 3) * RCH, tok + (c + 3) * RCH, hc); }
            }
            if (c >= 1) rwkv_post(YY + ((c - 1) & 1) * RV1, pvA, gwA, P, Y + (mb + (size_t)(c - 1) * RCH) * D + hc, tok, cq);
            pvA = pvB; gwA = gwB; pvB = pvN; gwB = gwN;
            __syncthreads();
        }
        rwkv_post(YY + ((NCH - 1) & 1) * RV1, pvA, gwA, P, Y + (mb + (size_t)(NCH - 1) * RCH) * D + hc, tok, cq);
        if (do_cvt && cpend >= 0) { const CvtDesc dd = cvt_desc(a, cpend, lane); cvt_store(cvb, dd); }
    }
    __syncthreads();
}

typedef short bf16x8_t __attribute__((ext_vector_type(8)));
typedef float f32x16_t __attribute__((ext_vector_type(16)));
__device__ __forceinline__ void sba_task(int task, const bf16* p, const bf16* VT, bf16* Y, int lane) {
    const int qb = task & 63, h = (task >> 6) & 31, b = task >> 11;
    const int n = lane & 31, hi = lane >> 5;
    const int t = 32 * qb + n; const size_t mq = (size_t)b * T + t;
    bf16x8_t qf[4];
#pragma unroll
    for (int s = 0; s < 4; ++s) { float f[8]; unpack8(*(const v4u*)(p + mq * NIN0P + RPROJ + h * 64 + 16 * s + 8 * hi), f);
#pragma unroll
        for (int e = 0; e < 8; ++e) f[e] *= 0.125f;
        qf[s] = __builtin_bit_cast(bf16x8_t, pack8(f)); }
    f32x16_t o0, o1;
#pragma unroll
    for (int r = 0; r < 16; ++r) { o0[r] = 0.f; o1[r] = 0.f; }
    float R = 1.f;
    const bf16* kbase = p + ((size_t)b * T + n) * NIN0P + RPROJ + 2048 + h * 64 + 8 * hi;
    const bf16* vbase = VT + (size_t)(h * 64 + n) * M + (size_t)b * T + 4 * hi;
    bf16x8_t kf[4]; v2u vf[2][2][2];
#define SBA_LOAD(k0_) do { _Pragma("unroll") for (int s = 0; s < 4; ++s) kf[s] = *(const bf16x8_t*)(kbase + (size_t)(k0_) * NIN0P + 16 * s); \
        _Pragma("unroll") for (int dh = 0; dh < 2; ++dh) _Pragma("unroll") for (int s = 0; s < 2; ++s) { const bf16* vp_ = vbase + (size_t)dh * 32 * M + (k0_) + 16 * s; vf[dh][s][0] = *(const v2u*)(vp_); vf[dh][s][1] = *(const v2u*)(vp_ + 8); } } while (0)
    SBA_LOAD(32 * qb);
    for (int kt = qb; kt >= 0; --kt) {
        f32x16_t z;
#pragma unroll
        for (int r = 0; r < 16; ++r) z[r] = 0.f;
#pragma unroll
        for (int s = 0; s < 4; ++s) z = __builtin_amdgcn_mfma_f32_32x32x16_bf16(kf[s], qf[s], z, 0, 0, 0);
        bf16x8_t va[2][2];
#pragma unroll
        for (int dh = 0; dh < 2; ++dh)
#pragma unroll
            for (int s = 0; s < 2; ++s) { v4u w_; w_.x = vf[dh][s][0].x; w_.y = vf[dh][s][0].y; w_.z = vf[dh][s][1].x; w_.w = vf[dh][s][1].y; va[dh][s] = __builtin_bit_cast(bf16x8_t, w_); }
        if (kt > 0) SBA_LOAD(32 * (kt - 1));
        const bool diag = (kt == qb);
        float kp[16], bt[16];
#pragma unroll
        for (int r = 0; r < 16; ++r) {
            const int key = (r & 3) + 8 * (r >> 2) + 4 * hi;
            const bool valid = !diag || key < n;
            const float kv = __builtin_amdgcn_rcpf(1.0f + __expf(z[r]));
            kp[r] = valid ? kv : 1.0f;
            bt[r] = valid ? 1.0f - kv : 0.0f;
        }
        float Gs[4], Gp[4];
#pragma unroll
        for (int g = 0; g < 4; ++g) { Gs[g] = (kp[4 * g] * kp[4 * g + 1]) * (kp[4 * g + 2] * kp[4 * g + 3]); Gp[g] = __shfl_xor(Gs[g], 32); }
        float base = R;
        f32x16_t pr;
#pragma unroll
        for (int g = 3; g >= 0; --g) {
            float c = base * (hi == 0 ? Gp[g] : 1.0f);
            pr[4 * g + 3] = bt[4 * g + 3] * c; c *= kp[4 * g + 3];
            pr[4 * g + 2] = bt[4 * g + 2] * c; c *= kp[4 * g + 2];
            pr[4 * g + 1] = bt[4 * g + 1] * c; c *= kp[4 * g + 1];
            pr[4 * g + 0] = bt[4 * g + 0] * c;
            base *= Gs[g] * Gp[g];
        }
        R = base;
#pragma unroll
        for (int s = 0; s < 2; ++s) {
            v4u pw; pw.x = pk2(pr[8 * s], pr[8 * s + 1]); pw.y = pk2(pr[8 * s + 2], pr[8 * s + 3]); pw.z = pk2(pr[8 * s + 4], pr[8 * s + 5]); pw.w = pk2(pr[8 * s + 6], pr[8 * s + 7]);
            const bf16x8_t pb = __builtin_bit_cast(bf16x8_t, pw);
            o0 = __builtin_amdgcn_mfma_f32_32x32x16_bf16(va[0][s], pb, o0, 0, 0, 0);
            o1 = __builtin_amdgcn_mfma_f32_32x32x16_bf16(va[1][s], pb, o1, 0, 0, 0);
        }
        if (__all(R < 1e-37f)) break;
    }
#undef SBA_LOAD
    bf16* orow = Y + mq * D + RW + h * 64 + 4 * hi;
#pragma unroll
    for (int g = 0; g < 4; ++g) {
        v2u w0; w0.x = pk2(o0[4 * g], o0[4 * g + 1]); w0.y = pk2(o0[4 * g + 2], o0[4 * g + 3]); *(v2u*)(orow + 8 * g) = w0;
        v2u w1; w1.x = pk2(o1[4 * g], o1[4 * g + 1]); w1.y = pk2(o1[4 * g + 2], o1[4 * g + 3]); *(v2u*)(orow + 32 + 8 * g) = w1;
    }
}

__device__ __forceinline__ void lru_elem(const float (&rp)[8], const float (&ip)[8], const float (&xv)[8], const float (&rb)[8], const float (&ib)[8], const float (&sl)[8], bool first, float (&av)[8], float (&uv)[8]) {
#pragma unroll
    for (int e = 0; e < 8; ++e) {
        const float rg = sigmoidf_(rp[e] + rb[e]), ig = sigmoidf_(ip[e] + ib[e]);
        const float la = -rg * sl[e]; av[e] = __expf(la);
        float mult = __builtin_amdgcn_sqrtf(-expm1f(2.0f * la)); if (first) mult = 1.0f;
        uv[e] = mult * ig * xv[e];
    }
}
__device__ __forceinline__ void lru_task(const Args& a, LAS float* L, int task, const bf16* RI, const bf16* xbc, const bf16* gg, bf16* Y) {
    const int tid = threadIdx.x, lane = tid & 63, w = tid >> 6;
    const int ts = lane >> 3, co = lane & 7;
    const int b = task >> 6, c = (task & 63) * 64 + co * 8;
    float rb[8], ib[8], sl[8];
#pragma unroll
    for (int e = 0; e < 8; ++e) { rb[e] = a.in[26][c + e]; ib[e] = a.in[28][c + e]; sl[e] = 8.0f * softplusf_(-a.in[29][c + e]); }
    const int t0 = 256 * w + 32 * ts; const size_t m0 = (size_t)b * T + t0;
    float P[8], H[8];
#pragma unroll
    for (int e = 0; e < 8; ++e) { P[e] = 1.f; H[e] = 0.f; }
#pragma unroll 2
    for (int i = 0; i < 32; ++i) {
        const size_t m = m0 + i;
        float rp[8], ip[8], xv[8], av[8], uv[8];
        unpack8(*(const v4u*)(RI + m * 8192 + c), rp); unpack8(*(const v4u*)(RI + m * 8192 + 4096 + c), ip); unpack8(*(const v4u*)(xbc + m * D + c), xv);
        lru_elem(rp, ip, xv, rb, ib, sl, (t0 + i) == 0, av, uv);
#pragma unroll
        for (int e = 0; e < 8; ++e) { H[e] = av[e] * H[e] + uv[e]; P[e] *= av[e]; }
    }
    float Pin[8], Hin[8];
#pragma unroll
    for (int e = 0; e < 8; ++e) { Pin[e] = P[e]; Hin[e] = H[e]; }
#pragma unroll
    for (int d = 8; d < 64; d <<= 1) {
#pragma unroll
        for (int e = 0; e < 8; ++e) { const float pp = __shfl_up(Pin[e], d), hh = __shfl_up(Hin[e], d); if (lane >= d) { Hin[e] = Pin[e] * hh + Hin[e]; Pin[e] = Pin[e] * pp; } }
    }
    float Pex[8], Hex[8];
#pragma unroll
    for (int e = 0; e < 8; ++e) { const float pp = __shfl_up(Pin[e], 8), hh = __shfl_up(Hin[e], 8); Pex[e] = ts ? pp : 1.f; Hex[e] = ts ? hh : 0.f; }
    if (ts == 7) {
#pragma unroll
        for (int e = 0; e < 8; ++e) { L[(w * 64 + co * 8 + e) * 2] = Pin[e]; L[(w * 64 + co * 8 + e) * 2 + 1] = Hin[e]; }
    }
    __syncthreads();
    float hc[8];
#pragma unroll
    for (int e = 0; e < 8; ++e) hc[e] = 0.f;
    for (int j = 0; j < w; ++j) {
#pragma unroll
        for (int e = 0; e < 8; ++e) hc[e] = L[(j * 64 + co * 8 + e) * 2] * hc[e] + L[(j * 64 + co * 8 + e) * 2 + 1];
    }
#pragma unroll
    for (int e = 0; e < 8; ++e) H[e] = Pex[e] * hc[e] + Hex[e];
#pragma unroll 2
    for (int i = 0; i < 32; ++i) {
        const size_t m = m0 + i;
        float rp[8], ip[8], xv[8], gv[8], av[8], uv[8];
        unpack8(*(const v4u*)(RI + m * 8192 + c), rp); unpack8(*(const v4u*)(RI + m * 8192 + 4096 + c), ip); unpack8(*(const v4u*)(xbc + m * D + c), xv); unpack8(*(const v4u*)(gg + m * D + c), gv);
        lru_elem(rp, ip, xv, rb, ib, sl, (t0 + i) == 0, av, uv);
        float yo[8];
#pragma unroll
        for (int e = 0; e < 8; ++e) { H[e] = av[e] * H[e] + uv[e]; yo[e] = H[e] * gv[e]; }
        *(v4u*)(Y + m * D + c) = pack8(yo);
    }
    __syncthreads();
}


#define IN(k) (lo <= (k) && (k) < hi)
#define SEAM(k) do { if (IN(k) && IN((k) + 1)) xcd_barrier(bar); } while (0)
#define SEAML(k) do { if (IN(k) && IN((k) + 1)) { if (lok) xcd_local_barrier(ctlw, bar.bar, bx & 7, (unsigned)(G >> 3)); else xcd_barrier(bar); } } while (0)

template <int Lyr>
__device__ __forceinline__ void layer_body(const Args& args, LAS unsigned char* lds, const XcdBarrier& bar) {
    const int tid = threadIdx.x, lane = tid & 63, wave = __builtin_amdgcn_readfirstlane(tid >> 6);
    const int G = gridDim.x, bx = blockIdx.x;
    const int gw = bx * NWAVES + wave, NGW = G * NWAVES;
    const size_t gt = (size_t)bx * NTHR + tid, NGT = (size_t)G * NTHR;
    unsigned char* ws = args.ws;
    const int lo = args.ph_lo, hi = args.ph_hi;
    bf16* Win = (bf16*)(ws + WS_WIN); bf16* Wout = (bf16*)(ws + (Lyr ? WS_W1P : WS_WOUT)); bf16* Wup = (bf16*)(ws + (Lyr ? WS_W1P + 32 * MiB : WS_WUP)); bf16* Wdown = (bf16*)(ws + (Lyr ? WS_W1P + 204 * MiB : WS_WDOWN));
    bf16* Wl1 = (bf16*)(ws + WS_WL1); bf16* Wg2 = (bf16*)(ws + WS_WG2); bf16* Wgates = (bf16*)(ws + WS_WGATES);
    bf16* A0 = (bf16*)(ws + WS_A0); bf16* BIG = (bf16*)(ws + WS_BIG); bf16* Yb = (bf16*)(ws + WS_Y); float* Sf = args.out; bf16* Sb = (bf16*)(ws + WS_U);
    float* SBf = (float*)(ws + WS_SB); float* Stt = (float*)(ws + WS_CTL + MiB);
    float* WApre = (float*)(ws + WS_U); bf16* Gb = (bf16*)(ws + WS_U + 256 * MiB); bf16* Ap = (bf16*)(ws + WS_U + 320 * MiB); bf16* Gp = (bf16*)(ws + WS_U + 328 * MiB);
    bf16* XBC = (bf16*)(ws + WS_BIG + 256 * MiB); bf16* GGb = (bf16*)(ws + WS_BIG); bf16* VT = (bf16*)(ws + WS_BIG + 336 * MiB); bf16* RI = (bf16*)(ws + WS_U);

        const int pb = Lyr * 11;
        const float* w_out = Lyr ? args.in[30] : args.in[13];
        const float* ln1g = Lyr ? args.in[31] : args.in[14]; const float* ln1b = Lyr ? args.in[32] : args.in[15];
        const float* ffn_up = Lyr ? args.in[33] : args.in[16]; const float* cw = Lyr ? args.in[34] : args.in[17]; const float* cb = Lyr ? args.in[35] : args.in[18];
        const float* ffn_down = Lyr ? args.in[36] : args.in[19];
        const float* ln2g = Lyr ? args.in[37] : args.in[20]; const float* ln2b = Lyr ? args.in[38] : args.in[21];
        const float* w_in = Lyr ? args.in[22] : args.in[1];
        const int n_in = Lyr ? 8192 : NIN0;

        if (IN(pb + 0)) {
            LAS float* scr = (LAS float*)(lds + RING_OFF + wave * 16384);
            const int I_IN = 64 * (n_in / 32), I_X = Lyr ? 32 * 32 : 4 * 64;
            const int NIT = I_IN + I_X;
            for (int it = gw; it < NIT; it += NGW) {
                int r = it;
                if (r < I_IN) { transpose_item(w_in, D, n_in, Win, 0, scr, r, lane); continue; } r -= I_IN;
                if (Lyr == 0) transpose_item(args.in[7], 256, 2048, Wg2, 0, scr, r, lane);
                else { const int mat = r >> 5, sub = r & 31, gsel = mat >> 4, hh = mat & 15;
                    const int n0 = 32 * (sub & 7); const int row = 256 * (2 * hh + (n0 >> 7)) + 128 * gsel + (n0 & 127);
                    transpose_item((gsel ? args.in[27] : args.in[25]) + (size_t)hh * 65536, 256, 256, Wgates, row - n0, scr, sub, lane); }
            }
            if (Lyr == 0) {
                for (size_t i = gt; i < (size_t)4096 * 256; i += NGT) { const int n = (int)(i >> 8), k = (int)(i & 255); float v = 0.f;
                    if (n < 2048) { if (k < 96) v = args.in[4][(size_t)k * 2048 + n]; } else { if (k >= 96 && k < 192) v = args.in[6][(size_t)(k - 96) * 2048 + (n - 2048)]; }
                    Wl1[i] = (bf16)f2bf(v); }
                for (size_t i = gt; i < (size_t)M * D / 8; i += NGT) { const f32x4 v0 = ((const f32x4*)args.in[0])[2 * i], v1 = ((const f32x4*)args.in[0])[2 * i + 1];
                    v4u o; o.x = pk2(v0.x, v0.y); o.y = pk2(v0.z, v0.w); o.z = pk2(v1.x, v1.y); o.w = pk2(v1.z, v1.w); ((v4u*)A0)[i] = o; }
            }
        }
        SEAM(pb + 0);
        bool lok = false;
        unsigned* const ctlw = (unsigned*)(ws + WS_CTL);
        if (!MK_PER_PHASE && G == 256) {
            volatile LAS unsigned* MISCw = (volatile LAS unsigned*)(lds + MISC_OFF);
            if (tid == 0) { unsigned okv = 1u;
                for (int c = 0; c < 8; ++c) { const unsigned mm = xb_ld(&ctlw[LB_MAP(c)]); okv &= (mm != 0u && (mm & (mm - 1u)) == 0u) ? 1u : 0u; }
                MISCw[12] = okv; }
            __syncthreads();
            lok = __builtin_amdgcn_readfirstlane((int)MISCw[12]) != 0;
            __syncthreads();
        }
        const int lnm0 = lok ? 2048 * (bx & 7) + (bx >> 3) * NWAVES + wave : gw, lnms = lok ? 256 : NGW, lnme = lok ? 2048 * (bx & 7) + 2048 : M;

        if (Lyr == 0) {
            if (IN(1)) {
                { pg8::Gemm g{A0, Win, M, NIN0P, D, D, 0, 0}; pg8::StaticOrder S; S.init(M, NIN0P, G, bx); pg8::EpiBf16 E{BIG, NIN0P};
                  pg8::gemm_phase<pg8::EpiBf16, pg8::StaticOrder, true, true>(lds + RING_OFF, g, S, E); }
                __syncthreads();
                { pg8::Gemm g{Win + (size_t)NVT0 * D, A0, 2048, M, D, D, 0, 0}; pg8::StaticOrder S; S.init(2048, M, G, bx); pg8::EpiBf16 E{VT, M};
                  pg8::gemm_phase<pg8::EpiBf16, pg8::StaticOrder, true, true>(lds + RING_OFF, g, S, E); }
            }
            SEAM(1);
            if (IN(2)) {
                for (int m = gw; m < M; m += NGW) {
                    const int t = m & (T - 1); const int sl = 8 * lane;
                    const bool isA = sl < 256; const int pc = isA ? 6144 + sl : 6336 + (sl - 256);
                    float f[8];
                    if (isA && sl >= 192) {
#pragma unroll
                        for (int e = 0; e < 8; ++e) f[e] = 0.f;
                    } else {
                        float c1[8], c0[8]; unpack8(*(const v4u*)(BIG + (size_t)m * NIN0P + pc), c1);
                        if (t > 0) unpack8(*(const v4u*)(BIG + (size_t)(m - 1) * NIN0P + pc), c0); else {
#pragma unroll
                            for (int e = 0; e < 8; ++e) c0[e] = 0.f; }
                        const f32x4 mu0 = *(const f32x4*)(args.in[2] + pc), mu1 = *(const f32x4*)(args.in[2] + pc + 4);
#pragma unroll
                        for (int e = 0; e < 8; ++e) { const float mu = e < 4 ? mu0[e] : mu1[e - 4]; const float xv = c1[e] + (c0[e] - c1[e]) * mu;
                            f[e] = isA ? (sl < 96 ? tanhf(xv) : xv) : sigmoidf_(xv); }
                    }
                    if (isA) *(v4u*)(Ap + (size_t)m * 256 + sl) = pack8(f); else *(v4u*)(Gp + (size_t)m * 256 + (sl - 256)) = pack8(f);
                }
            }
            SEAM(2);
            if (IN(3)) {
                { pg8::Gemm g{Ap, Wl1, M, 4096, 256, 256, 0, 0}; pg8::StaticOrder S; S.init(M, 4096, G, bx); pg8::EpiF32T<false> E{WApre, nullptr, 4096, 0.f, nullptr, nullptr, nullptr};
                  pg8::gemm_phase<pg8::EpiF32T<false>, pg8::StaticOrder, true, true>(lds + RING_OFF, g, S, E); }
                __syncthreads();
                { pg8::Gemm g{Gp, Wg2, M, 2048, 256, 256, 0, 0}; pg8::StaticOrder S; S.init(M, 2048, G, bx); pg8::EpiBf16 E{Gb, 2048};
                  pg8::gemm_phase<pg8::EpiBf16, pg8::StaticOrder, true, true>(lds + RING_OFF, g, S, E); }
            }
            SEAM(3);
            if (IN(4)) {
                { int nh = 0; for (int bh = bx; bh < BATCH * 32; bh += G, ++nh) rwkv_head(args, (LAS float*)(lds + RING_OFF), bh, BIG, WApre, Gb, Yb, true, nh * (T / RCH));
                  const int done_per_aw = nh * (T / RCH);
                  for (int it = done_per_aw * (G * 4) + gw; it < CV_TOTAL; it += 2 * NGW) {
                      float cva[32], cvb[32]; const CvtDesc da = cvt_desc(args, it, lane); cvt_load(cva, da);
                      const bool two = it + NGW < CV_TOTAL; const CvtDesc db = cvt_desc(args, two ? it + NGW : it, lane); if (two) cvt_load(cvb, db);
                      cvt_store(cva, da); if (two) cvt_store(cvb, db); } }
                __syncthreads();
                for (int task = gw; task < BATCH * 32 * 64; task += NGW) sba_task(task, BIG, VT, Yb, lane);
                __syncthreads();
            }
            SEAM(4);
        } else {
            if (IN(12)) { pg8::Gemm g{A0, Win, M, 8192, D, D, 0, 0}; pg8::StaticOrder S; S.init(M, 8192, G, bx); pg8::EpiLruIn E{GGb, XBC, args.in[23], args.in[24], SBf};
                pg8::gemm_phase<pg8::EpiLruIn, pg8::StaticOrder, true, true>(lds + RING_OFF, g, S, E); }
            SEAM(12);
            if (IN(14)) { pg8::Gemm g{XBC, Wgates, M, 8192, 256, D, 16, 256, 1}; pg8::ChainOrder S{G, bx};
                for (int chain = bx; chain < 256; chain += G) {
                    for (int i = tid; i < 16 * 3 * 32; i += NTHR) {
                        const int c = 256 * ((chain & 31) >> 1) + (i & 31) * 8, gi = i >> 5, gq = gi / 3, ti = gi - 3 * gq, grp = 16 * (chain >> 5) + gq;
                    const bool seq0 = (grp & 15) == 0;
                    float ov[8];
#pragma unroll
                    for (int q = 0; q < 2; ++q) {
                        const int cc = c + 4 * q;
                        const float* sb = SBf + (size_t)grp * 6 * 4096 + cc;
                        f32x4 xs[6];
#pragma unroll
                        for (int k = 0; k < 3; ++k) { xs[k] = seq0 ? (f32x4){0.f, 0.f, 0.f, 0.f} : *(const f32x4*)(sb - (size_t)(3 - k) * 4096); xs[3 + k] = *(const f32x4*)(sb + (size_t)k * 4096); }
                        f32x4 r = *(const f32x4*)(args.in[24] + cc);
#pragma unroll
                        for (int k = 0; k < 4; ++k) { const f32x4 wk = *(const f32x4*)(args.in[23] + (size_t)k * 4096 + cc);
                            const f32x4 xv = ti == 0 ? xs[k] : (ti == 1 ? xs[k + 1] : xs[k + 2]); r += wk * xv; }
#pragma unroll
                        for (int e = 0; e < 4; ++e) ov[4 * q + e] = r[e];
                    }
                    *(v4u*)(XBC + (size_t)(grp * 128 + ti) * D + c) = pack8(ov);
                    } }
                asm volatile("s_waitcnt vmcnt(0)" ::: "memory"); __syncthreads();
                pg8::EpiLruScan E{XBC, GGb, Yb, args.in[26], args.in[28], args.in[29], (LAS float*)(lds + RING_BYTES + 1024)};
                pg8::gemm_phase<pg8::EpiLruScan, pg8::ChainOrder, true, true>(lds + RING_OFF, g, S, E); }
            SEAM(14);
        }

        if (IN(pb + 5)) { pg8::Gemm g{Yb, Wout, M, D, D, D, 0, 0}; pg8::StaticOrder S; S.init(M, D, G, bx);
            pg8::EpiRes<Lyr == 1, false, Lyr == 0> E{Sb, Lyr ? (const void*)Sb : (const void*)A0, Stt, args.in[20], args.in[21]};
            pg8::gemm_phase<pg8::EpiRes<Lyr == 1, false, Lyr == 0>, pg8::StaticOrder, true, true>(lds + RING_OFF, g, S, E); }
        SEAML(pb + 5);
        if (IN(pb + 6)) ln_rows_b(Sb, ln1g, ln1b, A0, Stt, lnm0, lnms, lnme, lane);
        SEAML(pb + 6);
        if (IN(pb + 7)) { pg8::Gemm g{A0, Wup, M, FF2, D, D, 0, 0}; pg8::StaticOrder S; S.init(M, FF2, G, bx); pg8::EpiFfnUp E{BIG, cw, cb, SBf, FF};
            pg8::gemm_phase<pg8::EpiFfnUp, pg8::StaticOrder, true, true>(lds + RING_OFF, g, S, E); }
        SEAML(pb + 7);
        if (IN(pb + 8)) {
            const size_t fx0 = lok ? (size_t)(bx >> 3) * NTHR + tid : gt, fxs = lok ? (size_t)(G >> 3) * NTHR : NGT, fxn = (size_t)(lok ? 16 : 128) * 2 * (FF / 8); const int fxg = lok ? 16 * (bx & 7) : 0;
            for (size_t i = fx0; i < fxn; i += fxs) {
                const int c = (int)(i % (FF / 8)) * 8, gi = (int)(i / (FF / 8)), grp = fxg + (gi >> 1), ti = gi & 1;
                const bool seq0 = (grp & 15) == 0;
                float hv[8];
#pragma unroll
                for (int q = 0; q < 2; ++q) {
                    const int cc = c + 4 * q;
                    f32x4 cg, cv;
#pragma unroll
                    for (int gv = 0; gv < 2; ++gv) {
                        const int off = gv * FF + cc;
                        const float* sb = SBf + (size_t)grp * 4 * FF2 + off;
                        const f32x4 u0 = *(const f32x4*)(sb), u1 = *(const f32x4*)(sb + FF2);
                        f32x4 um1 = (f32x4){0.f, 0.f, 0.f, 0.f}, um2 = um1;
                        if (!seq0) { um2 = *(const f32x4*)(sb - 2 * FF2); um1 = *(const f32x4*)(sb - FF2); }
                        const f32x4 w0 = *(const f32x4*)(cw + off), w1 = *(const f32x4*)(cw + FF2 + off), w2 = *(const f32x4*)(cw + 2 * FF2 + off), bb = *(const f32x4*)(cb + off);
                        const f32x4 r = ti == 0 ? bb + w2 * u0 + w1 * um1 + w0 * um2 : bb + w2 * u1 + w1 * u0 + w0 * um1;
                        if (gv == 0) cg = r; else cv = r;
                    }
#pragma unroll
                    for (int e = 0; e < 4; ++e) hv[4 * q + e] = cg[e] * sigmoidf_(cg[e]) * cv[e];
                }
                *(v4u*)(BIG + (size_t)(grp * 128 + ti) * FF + c) = pack8(hv);
            }
        }
        SEAML(pb + 8);
        if (IN(pb + 9)) { pg8::Gemm g{BIG, Wdown, M, D, FF, FF, 0, 0}; pg8::StaticOrder S; S.init(M, D, G, bx); pg8::EpiRes<true, false> E{(void*)Sb, Sb, Stt, ln1g, ln1b};
            pg8::gemm_phase<pg8::EpiRes<true, false>, pg8::StaticOrder, true, true>(lds + RING_OFF, g, S, E); }
        SEAML(pb + 9);
        if (IN(pb + 10)) { if (Lyr) ln_rows_bf(Sb, ln2g, ln2b, args.out, lnm0, lnms, lnme, lane); else ln_rows_b(Sb, ln2g, ln2b, A0, Stt, lnm0, lnms, lnme, lane); }
        if (Lyr) SEAM(pb + 10);
    }
__global__ void __launch_bounds__(NTHR, 2) trunk_fwd(Args args) {
    extern __shared__ __attribute__((aligned(16))) unsigned char lds_raw[];
    LAS unsigned char* lds = (LAS unsigned char*)lds_raw;
    volatile LAS unsigned* MISC = (volatile LAS unsigned*)(lds + MISC_OFF);
    const int tid = threadIdx.x, lane = tid & 63, wave = __builtin_amdgcn_readfirstlane(tid >> 6);
    const int G = gridDim.x, bx = blockIdx.x;
    const int gw = bx * NWAVES + wave, NGW = G * NWAVES;
    const size_t gt = (size_t)bx * NTHR + tid, NGT = (size_t)G * NTHR;
    unsigned char* ws = args.ws;
    unsigned* ctl = (unsigned*)(ws + WS_CTL);
    for (int u = tid; u < (LDS_BYTES - LDSCTL_OFF) / 4; u += NTHR) ((LAS unsigned*)(lds + LDSCTL_OFF))[u] = 0u;
    __syncthreads();
    XcdBarrier bar; bar.bar = ctl + CW_BAR; bar.x = 0; bar.st = nullptr;
    if (!MK_PER_PHASE) { bar = xcd_barrier_post(ctl + CW_BAR, MISC + 8); if (tid == 0) (void)__hip_atomic_fetch_or(&ctl[LB_MAP(bx & 7)], 1u << bar.x, __ATOMIC_RELAXED, __HIP_MEMORY_SCOPE_AGENT); }

    layer_body<0>(args, lds, bar);
    layer_body<1>(args, lds, bar);
}


extern "C" void kernel_launch(void* const* d_in, const int* in_sizes, int n_in, void* d_out, int out_size, void* d_ws, size_t ws_size, hipStream_t stream) {
    static int grid = 0;
    if (grid == 0) {
        if (n_in != 39 || in_sizes[0] != M * D || out_size != M * D || ws_size < WS_END) {
            fprintf(stderr, "kernel_launch: unexpected shapes: n_in %d in0 %d out %d ws %zu (need %zu); nothing launched\n", n_in, n_in > 0 ? in_sizes[0] : -1, out_size, ws_size, (size_t)WS_END); grid = -1; return; }
        int dev = 0, cus = 0, per_cu = 0;
        if (hipGetDevice(&dev) != hipSuccess || hipDeviceGetAttribute(&cus, hipDeviceAttributeMultiprocessorCount, dev) != hipSuccess) { grid = -1; return; }
        if (hipFuncSetAttribute((const void*)trunk_fwd, hipFuncAttributeMaxDynamicSharedMemorySize, LDS_BYTES) != hipSuccess) { fprintf(stderr, "kernel_launch: hipFuncSetAttribute failed\n"); grid = -1; return; }
        if (hipOccupancyMaxActiveBlocksPerMultiprocessor(&per_cu, (const void*)trunk_fwd, NTHR, LDS_BYTES) != hipSuccess || per_cu < 1)
            fprintf(stderr, "kernel_launch: note: occupancy query reports %d workgroups per CU\n", per_cu);
        (void)hipGetLastError();
        grid = cus;
    }
    if (grid < 0) return;
    if (hipMemsetAsync((char*)d_ws + WS_CTL, 0, CTL_ZERO_BYTES, stream) != hipSuccess) return;
    Args a{};
    for (int i = 0; i < 39; ++i) a.in[i] = (const float*)d_in[i];
    a.out = (float*)d_out; a.ws = (unsigned char*)d_ws;
#if MK_PER_PHASE
    for (int ph = 0; ph < NPHASE; ++ph) { const int reps = ((PROBE_MASK >> ph) & 1u) ? 2 : 1; for (int r = 0; r < reps; ++r) { a.ph_lo = ph; a.ph_hi = ph + 1; hipLaunchKernelGGL(trunk_fwd, dim3(grid), dim3(NTHR), LDS_BYTES, stream, a); } }
#else
    a.ph_lo = 0; a.ph_hi = NPHASE;
    hipLaunchKernelGGL(trunk_fwd, dim3(grid), dim3(NTHR), LDS_BYTES, stream, a);
#endif
    const hipError_t le = hipPeekAtLastError();
    if (le != hipSuccess) fprintf(stderr, "kernel_launch: launch failed: %s\n", hipGetErrorName(le));
}
```
